# Optimizing an MI355X kernel written in HIP

```python
import jax, jax.numpy as jnp
from jax import lax
import numpy as np

D_MODEL = 1024
BATCH = 4
SEQ = 4096
DEPTH = 2

N_META = 16
CHUNK = 128
RET_HEADS = 8
RET_DK = D_MODEL // (2 * RET_HEADS)
RET_DV = 2 * RET_DK
SB_HEADS = 8
SB_DH = D_MODEL // (2 * SB_HEADS)
D_FF = ((8 * D_MODEL // 3 + 255) // 256) * 256
ROPE_BASE = 10000.0
EPS = 1e-6

COL_SIZES = [RET_HEADS * RET_DK, RET_HEADS * RET_DK, RET_HEADS * RET_DV, RET_HEADS * RET_DV,
             SB_HEADS * SB_DH, SB_HEADS * SB_DH, SB_HEADS * SB_DH, D_MODEL, D_MODEL]
D_IN = int(sum(COL_SIZES))
SPLITS = [int(s) for s in np.cumsum(COL_SIZES)[:-1]]

kernel_name = "hybrid_retention_stickbreaking_macaron"


def rmsnorm(x, g):
    xf = x.astype(jnp.float32)
    r = lax.rsqrt(jnp.mean(xf * xf, axis=-1, keepdims=True) + EPS)
    return (xf * r).astype(x.dtype) * g


def swiglu(x, w_gu, w_down):
    a, b = jnp.split(x @ w_gu, 2, axis=-1)
    return (jax.nn.silu(a) * b) @ w_down


def rotary(t, pos):
    dh = t.shape[-1]
    freqs = ROPE_BASE ** (-jnp.arange(0, dh, 2, dtype=jnp.float32) / dh)
    ang = pos[:, None] * freqs[None, :]
    cos, sin = jnp.cos(ang), jnp.sin(ang)
    tf = t.astype(jnp.float32)
    t1, t2 = tf[..., : dh // 2], tf[..., dh // 2:]
    return jnp.concatenate([t1 * cos - t2 * sin, t1 * sin + t2 * cos], axis=-1).astype(t.dtype)


def retention(q, k, v, valid):
    B, H, L, dk = q.shape
    dv = v.shape[-1]
    N = L // CHUNK
    log_gamma = jnp.log(1.0 - 2.0 ** (-5.0 - jnp.arange(H, dtype=jnp.float32)))
    vmask = valid.astype(jnp.float32)[None, None, :, None]
    qf = q.astype(jnp.float32).reshape(B, H, N, CHUNK, dk)
    kf = (k.astype(jnp.float32) * vmask * dk ** -0.5).reshape(B, H, N, CHUNK, dk)
    vf = (v.astype(jnp.float32) * vmask).reshape(B, H, N, CHUNK, dv)
    idx = jnp.arange(CHUNK, dtype=jnp.float32)
    diff = idx[:, None] - idx[None, :]
    decay = jnp.where(diff >= 0, jnp.exp(log_gamma[:, None, None] * jnp.maximum(diff, 0.0)), 0.0)
    scores = jnp.einsum('bhncd,bhnsd->bhncs', qf, kf) * decay[None, :, None]
    o_intra = jnp.einsum('bhncs,bhnse->bhnce', scores, vf)
    k_decay = jnp.exp(log_gamma[:, None] * (CHUNK - 1 - idx)[None, :])
    kv = jnp.einsum('bhnsd,bhnse->bhnde', kf * k_decay[None, :, None, :, None], vf)
    chunk_decay = jnp.exp(log_gamma * CHUNK)[None, :, None, None]

    def step(R, kv_n):
        return R * chunk_decay + kv_n, R

    _, R_prev = lax.scan(step, jnp.zeros((B, H, dk, dv), jnp.float32), jnp.moveaxis(kv, 2, 0))
    R_prev = jnp.moveaxis(R_prev, 0, 2)
    q_decay = jnp.exp(log_gamma[:, None] * (idx + 1.0)[None, :])
    o_cross = jnp.einsum('bhncd,bhnde->bhnce', qf, R_prev) * q_decay[None, :, None, :, None]
    return (o_intra + o_cross).reshape(B, H, L, dv)


def stick_breaking(q, k, v, valid):
    B, H, L, dh = q.shape
    NB = L // CHUNK
    kf = k.astype(jnp.float32)
    vf = v.astype(jnp.float32)
    qb = jnp.moveaxis(q.astype(jnp.float32).reshape(B, H, NB, CHUNK, dh), 2, 0)
    kpos = jnp.arange(L)
    scale = dh ** -0.5

    def block(args):
        q_blk, n = args
        qpos = n * CHUNK + jnp.arange(CHUNK)
        z = jnp.einsum('bhqd,bhkd->bhqk', q_blk, kf) * scale
        mask = ((kpos[None, :] < qpos[:, None]) & valid[None, :])[None, None]
        log_1mb = jnp.where(mask, jax.nn.log_sigmoid(-z), 0.0)
        acc = lax.cumsum(log_1mb, axis=3, reverse=True) - log_1mb
        a = jnp.where(mask, jnp.exp(jax.nn.log_sigmoid(z) + acc), 0.0)
        return jnp.einsum('bhqk,bhkd->bhqd', a, vf)

    o = lax.map(block, (qb, jnp.arange(NB)))
    return jnp.moveaxis(o, 0, 2).reshape(B, H, L, dh)


def mixer(u, w_in, ret_gn, w_ret_proj, w_sb_proj, w_out, pos, valid):
    B, L, _ = u.shape
    rq, rk, rv, rg, sq, sk, sv, ga, gb = jnp.split(u @ w_in, SPLITS, axis=-1)

    def heads(t, n):
        return t.reshape(B, L, n, -1).transpose(0, 2, 1, 3)

    o_r = retention(rotary(heads(rq, RET_HEADS), pos), rotary(heads(rk, RET_HEADS), pos),
                    heads(rv, RET_HEADS), valid)
    mu = jnp.mean(o_r, axis=-1, keepdims=True)
    var = jnp.mean(jnp.square(o_r - mu), axis=-1, keepdims=True)
    o_r = ((o_r - mu) * lax.rsqrt(var + EPS)).transpose(0, 2, 1, 3).reshape(B, L, RET_HEADS * RET_DV)
    y_ret = (jax.nn.silu(rg) * (o_r.astype(u.dtype) * ret_gn)) @ w_ret_proj
    o_s = stick_breaking(heads(sq, SB_HEADS), heads(sk, SB_HEADS), heads(sv, SB_HEADS), valid)
    y_sb = o_s.transpose(0, 2, 1, 3).reshape(B, L, SB_HEADS * SB_DH).astype(u.dtype) @ w_sb_proj
    return (jax.nn.sigmoid(ga) * y_ret + jax.nn.sigmoid(gb) * y_sb) @ w_out


def setup_inputs(seed: int = 0) -> dict:
    key = jax.random.key(seed)
    ks = jax.random.split(key, 20)
    f32 = jnp.float32

    def w(k, shape, fan_in):
        return jax.random.normal(k, shape, f32) * fan_in ** -0.5

    def gain(k, shape):
        return 1.0 + 0.01 * jax.random.normal(k, shape, f32)

    return {
        "x": jax.random.normal(ks[0], (BATCH, SEQ, D_MODEL), f32),
        "meta": jax.random.normal(ks[1], (N_META, D_MODEL), f32),
        "ffn1_norm": gain(ks[2], (DEPTH, D_MODEL)),
        "ffn1_w_gu": w(ks[3], (DEPTH, D_MODEL, 2 * D_FF), D_MODEL),
        "ffn1_w_down": w(ks[4], (DEPTH, D_FF, D_MODEL), D_FF),
        "mix_norm": gain(ks[5], (DEPTH, D_MODEL)),
        "w_in": w(ks[6], (DEPTH, D_MODEL, D_IN), D_MODEL),
        "ret_gn": gain(ks[7], (DEPTH, RET_HEADS * RET_DV)),
        "w_ret_proj": w(ks[8], (DEPTH, RET_HEADS * RET_DV, D_MODEL), RET_HEADS * RET_DV),
        "w_sb_proj": w(ks[9], (DEPTH, SB_HEADS * SB_DH, D_MODEL), SB_HEADS * SB_DH),
        "w_out": w(ks[10], (DEPTH, D_MODEL, D_MODEL), D_MODEL),
        "ffn2_norm": gain(ks[11], (DEPTH, D_MODEL)),
        "ffn2_w_gu": w(ks[12], (DEPTH, D_MODEL, 2 * D_FF), D_MODEL),
        "ffn2_w_down": w(ks[13], (DEPTH, D_FF, D_MODEL), D_FF),
        "final_norm": gain(ks[14], (D_MODEL,)),
    }


def reference(x, meta, ffn1_norm, ffn1_w_gu, ffn1_w_down, mix_norm, w_in, ret_gn,
              w_ret_proj, w_sb_proj, w_out, ffn2_norm, ffn2_w_gu, ffn2_w_down, final_norm):
    B, S, D = x.shape
    pad = CHUNK - N_META
    h = jnp.concatenate([jnp.zeros((B, pad, D), x.dtype),
                         jnp.broadcast_to(meta.astype(x.dtype)[None], (B, N_META, D)), x], axis=1)
    L = S + CHUNK
    idx = jnp.arange(L)
    valid = idx >= pad
    pos = (idx - pad).astype(jnp.float32)
    for l in range(DEPTH):
        h = h + 0.5 * swiglu(rmsnorm(h, ffn1_norm[l]), ffn1_w_gu[l], ffn1_w_down[l])
        h = h + mixer(rmsnorm(h, mix_norm[l]), w_in[l], ret_gn[l], w_ret_proj[l],
                      w_sb_proj[l], w_out[l], pos, valid)
        h = h + 0.5 * swiglu(rmsnorm(h, ffn2_norm[l]), ffn2_w_gu[l], ffn2_w_down[l])
    h = rmsnorm(h, final_norm)
    return h[:, CHUNK:]
```

```cpp
#include <hip/hip_runtime.h>
#include <hip/hip_cooperative_groups.h>
#include <cstdio>
#include <cstdint>
namespace cg = cooperative_groups;

constexpr int DM = 1024, NBATCH = 4, SEQ = 4096, LSEQ = 4224, DFF = 2816, DIN = 6656;
constexpr int MR = NBATCH * SEQ;
constexpr int MX = NBATCH * 128;
constexpr int M = MR + MX;
constexpr float EPS = 1e-6f;
constexpr float LOG2E = 1.4426950408889634f;
constexpr float SBC2 = 0.125f * LOG2E;

constexpr size_t MiB = 1u << 20;
constexpr size_t WS_CTL = 0, CTL_ZERO_BYTES = 1 * MiB;
constexpr size_t WS_TAB = 1 * MiB;
constexpr size_t WS_SS = 3 * MiB;
constexpr size_t WS_HSIDE = 4 * MiB;
constexpr size_t WS_W = 6 * MiB;
constexpr size_t W_GU1 = 0, W_DN1 = W_GU1 + (size_t)2 * DFF * DM * 2, W_IN = W_DN1 + (size_t)DM * DFF * 2, W_RET = W_IN + (size_t)DIN * DM * 2,
                 W_SB = W_RET + (size_t)DM * DM * 2, W_OUT = W_SB + (size_t)DM * 512 * 2, W_GU2 = W_OUT + (size_t)DM * DM * 2, W_DN2 = W_GU2 + (size_t)2 * DFF * DM * 2,
                 W_END = W_DN2 + (size_t)DM * DFF * 2;
static_assert(W_END <= 52 * MiB, "weights");
constexpr size_t WS_HB = 58 * MiB;
constexpr size_t WS_RP = 91 * MiB;
constexpr size_t SZ512 = (size_t)M * 512 * 2, SZ1024 = (size_t)M * 1024 * 2;
constexpr size_t WS_RQ = WS_RP, WS_RK = WS_RQ + SZ512, WS_RV = WS_RK + SZ512, WS_RG = WS_RV + SZ1024, WS_SQ = WS_RG + SZ1024, WS_SK = WS_SQ + SZ512, WS_SV = WS_SK + SZ512, WS_END = WS_SV + SZ512;
constexpr size_t WS_KV = WS_END;
static_assert(WS_KV + (size_t)32 * 33 * 16384 <= 256 * MiB, "kv");
constexpr size_t WS_ACT = WS_RP;
constexpr size_t WS_GA = WS_RQ, WS_GB = WS_RV, WS_Y = WS_SK;
static_assert(WS_END <= 256 * MiB && (size_t)M * DFF * 2 <= WS_END - WS_RP, "ws map");
constexpr int CW_BAR = 4096, CW_Q = 16384;

namespace pg8 {
#define PG8_LAS __attribute__((address_space(3)))
typedef unsigned short bf16_t;
typedef short bf16x8 __attribute__((ext_vector_type(8)));
typedef float f32x4 __attribute__((ext_vector_type(4)));
typedef unsigned u32x4 __attribute__((ext_vector_type(4)));
constexpr int BM = 256, BK = 64, HALF = 128, HTB = HALF * BK * 2  , STAGE_BYTES = 8 * HTB, NXCD = 8, WGM = 8;

__host__ __device__ __forceinline__ int lds_byte(int r, int c) { const int st = (r >> 4) * 2 + (c >> 5), rr = r & 15, cc = c & 31, ob = rr * 64 + cc * 2; return st * 1024 + (ob ^ (((ob >> 9) & 1) << 5)); }
__host__ __device__ __forceinline__ void stage_rc(int b, int& R, int& C) { const int st = b / 1024, sb = b % 1024, swz = sb ^ (((sb >> 9) & 1) << 5); R = (st >> 1) * 16 + swz / 64; C = (st & 1) * 32 + (swz % 64) / 2; }
__host__ __device__ __forceinline__ int perm32(int rho) { const int n = rho >> 4, i = rho & 15; return 8 * (i >> 2) + 4 * n + (i & 3); }

struct Unit { int pm, pn; };
struct Gemm { const bf16_t* A; const bf16_t* Bt; int M, N, K; };

struct StaticOrder {
    int nM, nN, nwg, G, c;
    __host__ __device__ void init(int M, int N, int G_, int c_) { nM = M / BM; nN = N / BM; nwg = nM * nN; G = G_; c = c_; }
    __host__ __device__ bool next(int i, Unit& u) const {
        const long L = (long)i * G + c; if (L >= nwg) return false;
        int wgid = (int)L; { const int q = nwg / NXCD, r = nwg % NXCD, xcd = wgid % NXCD, off = wgid / NXCD; wgid = (xcd < r ? xcd * (q + 1) : r * (q + 1) + (xcd - r) * q) + off; }
        const int nig = WGM * nN, gid = wgid / nig, fm = gid * WGM, gsz = (nM - fm) < WGM ? (nM - fm) : WGM;
        u.pm = fm + ((wgid % nig) % gsz); u.pn = (wgid % nig) / gsz; return true;
    }
    __device__ __forceinline__ void a_ready(const Unit&) const {}
    __device__ __forceinline__ void done(const Unit&) const {}
};

typedef float f32x2c_t __attribute__((ext_vector_type(2))); typedef __bf16 bf16x2c_t __attribute__((ext_vector_type(2)));
__device__ __forceinline__ unsigned cvt_pk_bf16(float lo, float hi) { f32x2c_t v = {lo, hi}; bf16x2c_t b = __builtin_convertvector(v, bf16x2c_t); return __builtin_bit_cast(unsigned, b); }
typedef float f32x2 __attribute__((ext_vector_type(2)));
typedef unsigned u32x2 __attribute__((ext_vector_type(2)));
__device__ __forceinline__ float bf2f(unsigned short b) { return __builtin_bit_cast(float, (unsigned)b << 16); }
__device__ __forceinline__ float bflo(unsigned w) { return __builtin_bit_cast(float, w << 16); }
__device__ __forceinline__ float bfhi(unsigned w) { return __builtin_bit_cast(float, w & 0xffff0000u); }
__device__ __forceinline__ float fsigmoid(float x) { return __builtin_amdgcn_rcpf(1.0f + __builtin_amdgcn_exp2f(-x * 1.4426950408889634f)); }
typedef unsigned long long ss_t;
__device__ __forceinline__ float rowscale(const ss_t* ss, int row) { return __builtin_amdgcn_rsqf((float)ss[row] * (1.0f / (1024.0f * 1048576.0f)) + 1e-6f); }

struct EpiSwiGLU {
    static constexpr bool PERM = true, AFTER_DRAIN = false;
    bf16_t* O; const ss_t* ss;
    __device__ __forceinline__ void operator()(const f32x4 (&acc)[2][2][4][2], const Unit& u, int wr, int wc, int fr, int fq) const {
        const int row0 = u.pm * BM + wr * 64 + fr; const int col0 = u.pn * 128 + wc * 32 + 8 * fq;
#pragma unroll
        for (int ai = 0; ai < 2; ++ai)
#pragma unroll
            for (int m = 0; m < 4; ++m) { const int row = row0 + ai * HALF + m * 16; const float r = rowscale(ss, row);
                u32x4 w; unsigned* wp = (unsigned*)&w;
#pragma unroll
                for (int n = 0; n < 2; ++n) { float o[4];
#pragma unroll
                    for (int e = 0; e < 4; ++e) { const float a = acc[ai][0][m][n][e] * r, b = acc[ai][1][m][n][e] * r; o[e] = a * fsigmoid(a) * b; }
                    wp[2 * n] = cvt_pk_bf16(o[0], o[1]); wp[2 * n + 1] = cvt_pk_bf16(o[2], o[3]); }
                *(u32x4*)(O + (size_t)row * 2816 + col0) = w; }
    }
};
struct EpiResid {
    static constexpr bool PERM = false, AFTER_DRAIN = false;
    const float* Hsrc; float* Hmain; bf16_t* HB; ss_t* ssn; float s;
    __device__ __forceinline__ void operator()(const f32x4 (&acc)[2][2][4][2], const Unit& u, int wr, int wc, int fr, int fq) const {
        const int row0 = u.pm * BM + wr * 64 + fr; const int col0 = u.pn * BM + wc * 32 + 4 * fq;
#pragma unroll
        for (int ai = 0; ai < 2; ++ai)
#pragma unroll
            for (int m = 0; m < 4; ++m) { const int row = row0 + ai * HALF + m * 16; float* hp = Hmain + (size_t)row * 1024 + col0; const float* sp = Hsrc + (size_t)row * 1024 + col0; bf16_t* bp = HB + (size_t)row * 1024 + col0; float sq = 0.f;
#pragma unroll
                for (int bj = 0; bj < 2; ++bj)
#pragma unroll
                    for (int n = 0; n < 2; ++n) { f32x4 v = *(const f32x4*)(sp + bj * HALF + n * 16); v = v + acc[ai][bj][m][n] * s; *(f32x4*)(hp + bj * HALF + n * 16) = v;
                        sq += (v[0] * v[0] + v[1] * v[1]) + (v[2] * v[2] + v[3] * v[3]);
                        u32x2 w; w.x = cvt_pk_bf16(v[0], v[1]); w.y = cvt_pk_bf16(v[2], v[3]); *(u32x2*)(bp + bj * HALF + n * 16) = w; }
                sq += __shfl_xor(sq, 16); sq += __shfl_xor(sq, 32);
                if (fq == 0) atomicAdd(ssn + row, (ss_t)(sq * 1048576.0f + 0.5f)); asm volatile("" ::: "memory"); }
    }
};
struct EpiIn {
    static constexpr bool PERM = true, AFTER_DRAIN = false;
    unsigned char* ws; const ss_t* ss; int pn_off;
    __device__ __forceinline__ void operator()(const f32x4 (&acc)[2][2][4][2], const Unit& u, int wr, int wc, int fr, int fq) const {
        const int gpn = u.pn + pn_off; const int row0 = u.pm * BM + wr * 64 + fr;
        if (gpn < 4) {
            bf16_t* O = (bf16_t*)(ws + (gpn < 2 ? WS_RQ : WS_RK)); const float sc = gpn < 2 ? 1.0f : 0.125f;
            const int head = 4 * (gpn & 1) + wc, d0 = 8 * fq; const f32x4* tab = (const f32x4*)(ws + WS_TAB);
#pragma unroll
            for (int ai = 0; ai < 2; ++ai)
#pragma unroll
                for (int m = 0; m < 4; ++m) { const int row = row0 + ai * HALF + m * 16; const float r = rowscale(ss, row) * sc;
                    const int t = (row & 4095) + 128;
                    const f32x4* tp = tab + ((size_t)t * 32 + d0) / 2;
                    u32x4 w1, w2; unsigned* p1 = (unsigned*)&w1; unsigned* p2 = (unsigned*)&w2;
#pragma unroll
                    for (int n = 0; n < 2; ++n) { const f32x4 cs0 = tp[2 * n], cs1 = tp[2 * n + 1]; float o1[4], o2[4];
                        const float c[4] = {cs0[0], cs0[2], cs1[0], cs1[2]}, s[4] = {cs0[1], cs0[3], cs1[1], cs1[3]};
#pragma unroll
                        for (int e = 0; e < 4; ++e) { const float t1 = acc[ai][0][m][n][e] * r, t2 = acc[ai][1][m][n][e] * r; o1[e] = t1 * c[e] - t2 * s[e]; o2[e] = t1 * s[e] + t2 * c[e]; }
                        p1[2 * n] = cvt_pk_bf16(o1[0], o1[1]); p1[2 * n + 1] = cvt_pk_bf16(o1[2], o1[3]); p2[2 * n] = cvt_pk_bf16(o2[0], o2[1]); p2[2 * n + 1] = cvt_pk_bf16(o2[2], o2[3]); }
                    bf16_t* op = O + (size_t)row * 512 + 64 * head + d0; *(u32x4*)op = w1; *(u32x4*)(op + 32) = w2; }
            return;
        }
        size_t off; int pitch, t0, act; float sc = 1.0f;
        if (gpn < 8) { off = WS_RV; pitch = 1024; t0 = 4; act = 0; }
        else if (gpn < 12) { off = WS_RG; pitch = 1024; t0 = 8; act = 1; }
        else if (gpn < 14) { off = WS_SQ; pitch = 512; t0 = 12; act = 0; sc = SBC2; }
        else if (gpn < 16) { off = WS_SK; pitch = 512; t0 = 14; act = 0; }
        else if (gpn < 18) { off = WS_SV; pitch = 512; t0 = 16; act = 0; }
        else if (gpn < 22) { off = WS_GA; pitch = 1024; t0 = 18; act = 2; }
        else { off = WS_GB; pitch = 1024; t0 = 22; act = 2; }
        bf16_t* O = (bf16_t*)(ws + off); const int col0 = (gpn - t0) * 256 + wc * 32 + 8 * fq;
#pragma unroll
        for (int ai = 0; ai < 2; ++ai)
#pragma unroll
            for (int m = 0; m < 4; ++m) { const int row = row0 + ai * HALF + m * 16; const float r = rowscale(ss, row) * sc; bf16_t* op = O + (size_t)row * pitch + col0;
#pragma unroll
                for (int bj = 0; bj < 2; ++bj) { u32x4 w; unsigned* wp = (unsigned*)&w;
#pragma unroll
                    for (int n = 0; n < 2; ++n) { float o[4];
#pragma unroll
                        for (int e = 0; e < 4; ++e) { float v = acc[ai][bj][m][n][e] * r; if (act == 1) v = v * fsigmoid(v); else if (act == 2) v = fsigmoid(v); o[e] = v; }
                        wp[2 * n] = cvt_pk_bf16(o[0], o[1]); wp[2 * n + 1] = cvt_pk_bf16(o[2], o[3]); }
                    *(u32x4*)(op + bj * HALF) = w; } }
    }
};
template <bool FIRST> struct EpiProj {
    static constexpr bool PERM = true, AFTER_DRAIN = false;
    const bf16_t* G; bf16_t* Y;
    __device__ __forceinline__ void operator()(const f32x4 (&acc)[2][2][4][2], const Unit& u, int wr, int wc, int fr, int fq) const {
        const int row0 = u.pm * BM + wr * 64 + fr; const int col0 = u.pn * BM + wc * 32 + 8 * fq;
#pragma unroll
        for (int ai = 0; ai < 2; ++ai)
#pragma unroll
            for (int m = 0; m < 4; ++m) { const size_t o = (size_t)(row0 + ai * HALF + m * 16) * 1024 + col0;
#pragma unroll
                for (int bj = 0; bj < 2; ++bj) { const u32x4 g = *(const u32x4*)(G + o + bj * HALF); u32x4 y = {0u, 0u, 0u, 0u}; if (!FIRST) y = *(const u32x4*)(Y + o + bj * HALF);
                    const unsigned* gp = (const unsigned*)&g; unsigned* yp = (unsigned*)&y;
#pragma unroll
                    for (int n = 0; n < 2; ++n) { const f32x4 a = acc[ai][bj][m][n];
                        float v0 = bflo(gp[2 * n]) * a[0], v1 = bfhi(gp[2 * n]) * a[1], v2 = bflo(gp[2 * n + 1]) * a[2], v3 = bfhi(gp[2 * n + 1]) * a[3];
                        if (!FIRST) { v0 += bflo(yp[2 * n]); v1 += bfhi(yp[2 * n]); v2 += bflo(yp[2 * n + 1]); v3 += bfhi(yp[2 * n + 1]); }
                        yp[2 * n] = cvt_pk_bf16(v0, v1); yp[2 * n + 1] = cvt_pk_bf16(v2, v3); }
                    *(u32x4*)(Y + o + bj * HALF) = y; } }
    }
};
template <class Epi, class Sched, bool ALIGN_EPI = false, bool SP2 = false>
__device__ __forceinline__ void gemm_phase(PG8_LAS unsigned char* lds, const Gemm g, const Sched& S, const Epi& E) {
    int tid_ = threadIdx.x; asm volatile("" : "+v"(tid_));
    const int tid = tid_, wid = __builtin_amdgcn_readfirstlane(tid >> 6), lane = tid & 63, wr = wid >> 2, wc = wid & 3, fr = lane & 15, fq = lane >> 4;
    const int K = g.K, nt = K / BK;
    unsigned voffA[2], voffB[2];
#pragma unroll
    for (int i = 0; i < 2; ++i) { int R, C; stage_rc(tid * 16 + i * 8192, R, C); const int Rb = Epi::PERM ? ((R & ~31) + perm32(R & 31)) : R;
        voffA[i] = (unsigned)(R * K + C) * 2u; voffB[i] = (unsigned)(Rb * K + C) * 2u; }
    const size_t kstep = (size_t)(BK * 2);
    const size_t hstep = (size_t)HALF * K * 2;
    const size_t tstep = 2 * hstep;
    const unsigned ldsw = (unsigned)wid * 1024u;
    const int aoff = lds_byte(wr * 64 + fr, fq * 8), boff = lds_byte(wc * 32 + fr, fq * 8);
#define PG8_SA(b, h) (((b) * 2 + (h)) * HTB)
#define PG8_SB(b, h) ((4 + (b) * 2 + (h)) * HTB)
#define PG8_STAGE(bufoff, gbase, voff) do { _Pragma("unroll") for (int _i = 0; _i < 2; ++_i) \
        __builtin_amdgcn_global_load_lds((const unsigned*)((const char*)(gbase) + (voff)[_i]), (PG8_LAS unsigned*)(lds + (bufoff) + ldsw + _i * 8192), 16, 0, 0); } while (0)
#define PG8_LDA(dst, b, h) do { _Pragma("unroll") for (int m = 0; m < 4; ++m) _Pragma("unroll") for (int k = 0; k < 2; ++k) dst[m][k] = *(const PG8_LAS bf16x8*)(lds + PG8_SA(b, h) + aoff + m * 2048 + k * 1024); } while (0)
#define PG8_LDB(dst, b, h) do { _Pragma("unroll") for (int n = 0; n < 2; ++n) _Pragma("unroll") for (int k = 0; k < 2; ++k) dst[n][k] = *(const PG8_LAS bf16x8*)(lds + PG8_SB(b, h) + boff + n * 2048 + k * 1024); } while (0)
#define PG8_MMA(ai, bj, At, Bt) do { __builtin_amdgcn_s_setprio(1); _Pragma("unroll") for (int m = 0; m < 4; ++m) _Pragma("unroll") for (int n = 0; n < 2; ++n) _Pragma("unroll") for (int k = 0; k < 2; ++k) \
        acc[ai][bj][m][n] = __builtin_amdgcn_mfma_f32_16x16x32_bf16(Bt[n][k], At[m][k], acc[ai][bj][m][n], 0, 0, 0); __builtin_amdgcn_s_setprio(0); } while (0)
#define PG8_WAIT_V(n) asm volatile("s_waitcnt vmcnt(" #n ")" ::: "memory")
#define PG8_WAIT_L(n) asm volatile("s_waitcnt lgkmcnt(" #n ")" ::: "memory")
#define PG8_BAR __builtin_amdgcn_s_barrier()
#define PG8_SCHED __builtin_amdgcn_sched_barrier(0)
    Unit cur, nxt; int ui = 0;
    if (!S.next(0, cur)) return;
    f32x4 acc[2][2][4][2];
#pragma unroll
    for (int a = 0; a < 2; ++a)
#pragma unroll
        for (int b = 0; b < 2; ++b)
#pragma unroll
            for (int m = 0; m < 4; ++m)
#pragma unroll
                for (int n = 0; n < 2; ++n) acc[a][b][m][n] = (f32x4){0.f, 0.f, 0.f, 0.f};
    bf16x8 At[4][2], B0[2][2], B1[2][2];
    const char* cA = (const char*)g.A + (size_t)cur.pm * tstep; const char* cB = (const char*)g.Bt + (size_t)cur.pn * tstep;
    S.a_ready(cur);
    if constexpr (SP2) {
        PG8_STAGE(PG8_SB(0, 0), cB, voffB); PG8_STAGE(PG8_SB(0, 1), cB + hstep, voffB); PG8_STAGE(PG8_SA(0, 0), cA, voffA); PG8_STAGE(PG8_SA(0, 1), cA + hstep, voffA);
        if (wr == 1) PG8_BAR;
        PG8_WAIT_V(2); PG8_BAR;
        PG8_STAGE(PG8_SB(1, 0), cB + kstep, voffB); PG8_STAGE(PG8_SA(1, 0), cA + kstep, voffA); PG8_STAGE(PG8_SB(1, 1), cB + hstep + kstep, voffB);
        PG8_WAIT_V(6); PG8_BAR;
    } else {
        PG8_STAGE(PG8_SB(0, 0), cB, voffB); PG8_STAGE(PG8_SA(0, 0), cA, voffA); PG8_STAGE(PG8_SB(0, 1), cB + hstep, voffB); PG8_STAGE(PG8_SA(0, 1), cA + hstep, voffA);
        if (wr == 1) PG8_BAR;
        PG8_WAIT_V(4); PG8_BAR;
        PG8_STAGE(PG8_SB(1, 0), cB + kstep, voffB); PG8_STAGE(PG8_SA(1, 0), cA + kstep, voffA); PG8_STAGE(PG8_SB(1, 1), cB + hstep + kstep, voffB);
        PG8_WAIT_V(6); PG8_BAR;
    }
    for (;;) {
        const bool has_next = S.next(ui + 1, nxt);
        const char* nA = has_next ? (const char*)g.A + (size_t)nxt.pm * tstep : cA; const char* nB = has_next ? (const char*)g.Bt + (size_t)nxt.pn * tstep : cB;
        for (int t = 0; t < nt; t += 2) {
            const bool last = (t == nt - 2);
            const char* a1 = cA + (size_t)(t + 1) * kstep;
            const char* a2 = last ? nA : cA + (size_t)(t + 2) * kstep; const char* b2 = last ? nB : cB + (size_t)(t + 2) * kstep;
            const char* a3 = a2 + kstep; const char* b3 = b2 + kstep;
            if (last && has_next) S.a_ready(nxt);
            if constexpr (SP2) {
            PG8_LDB(B0, 0, 0); PG8_LDB(B1, 0, 1); PG8_SCHED; PG8_LDA(At, 0, 0); PG8_STAGE(PG8_SA(1, 1), a1 + hstep, voffA);
            PG8_WAIT_V(8); PG8_WAIT_L(0); PG8_BAR; PG8_MMA(0, 0, At, B0); PG8_MMA(0, 1, At, B1); PG8_BAR; PG8_SCHED;
            PG8_LDA(At, 0, 1); PG8_STAGE(PG8_SB(0, 0), b2, voffB); PG8_STAGE(PG8_SB(0, 1), b2 + hstep, voffB); PG8_STAGE(PG8_SA(0, 0), a2, voffA);
            PG8_WAIT_V(8); PG8_WAIT_L(0); PG8_BAR; PG8_MMA(1, 0, At, B0); PG8_MMA(1, 1, At, B1); PG8_BAR; PG8_SCHED;
            PG8_LDB(B0, 1, 0); PG8_LDB(B1, 1, 1); PG8_SCHED; PG8_LDA(At, 1, 0); PG8_STAGE(PG8_SA(0, 1), a2 + hstep, voffA);
            PG8_WAIT_V(8); PG8_WAIT_L(0); PG8_BAR; PG8_MMA(0, 0, At, B0); PG8_MMA(0, 1, At, B1); PG8_BAR; PG8_SCHED;
            PG8_LDA(At, 1, 1); PG8_STAGE(PG8_SB(1, 0), b3, voffB); PG8_STAGE(PG8_SB(1, 1), b3 + hstep, voffB); PG8_STAGE(PG8_SA(1, 0), a3, voffA);
            PG8_WAIT_V(8); PG8_WAIT_L(0); PG8_BAR; PG8_MMA(1, 0, At, B0); PG8_MMA(1, 1, At, B1); PG8_BAR; PG8_SCHED;
            } else {
            PG8_LDB(B0, 0, 0); PG8_SCHED; PG8_LDA(At, 0, 0); PG8_STAGE(PG8_SA(1, 1), a1 + hstep, voffA);
            PG8_WAIT_L(8); PG8_BAR; PG8_WAIT_L(0); PG8_MMA(0, 0, At, B0); PG8_BAR; PG8_SCHED;
            PG8_LDB(B1, 0, 1); PG8_STAGE(PG8_SB(0, 0), b2, voffB);
            PG8_BAR; PG8_WAIT_L(0); PG8_MMA(0, 1, At, B1); PG8_BAR;
            PG8_LDA(At, 0, 1); PG8_STAGE(PG8_SA(0, 0), a2, voffA);
            PG8_BAR; PG8_WAIT_L(0); PG8_MMA(1, 0, At, B0); PG8_BAR; PG8_SCHED;
            PG8_STAGE(PG8_SB(0, 1), b2 + hstep, voffB);
            PG8_WAIT_V(6); PG8_BAR; PG8_MMA(1, 1, At, B1); PG8_BAR;
            PG8_LDB(B0, 1, 0); PG8_SCHED; PG8_LDA(At, 1, 0); PG8_STAGE(PG8_SA(0, 1), a2 + hstep, voffA);
            PG8_WAIT_L(8); PG8_BAR; PG8_WAIT_L(0); PG8_MMA(0, 0, At, B0); PG8_BAR; PG8_SCHED;
            PG8_LDB(B1, 1, 1); PG8_STAGE(PG8_SB(1, 0), b3, voffB);
            PG8_BAR; PG8_WAIT_L(0); PG8_MMA(0, 1, At, B1); PG8_BAR;
            PG8_LDA(At, 1, 1); PG8_STAGE(PG8_SA(1, 0), a3, voffA);
            PG8_BAR; PG8_WAIT_L(0); PG8_MMA(1, 0, At, B0); PG8_BAR; PG8_SCHED;
            PG8_STAGE(PG8_SB(1, 1), b3 + hstep, voffB);
            PG8_WAIT_V(6); PG8_BAR; PG8_MMA(1, 1, At, B1); PG8_BAR;
            }
        }
        if constexpr (ALIGN_EPI) { if (wr == 0) PG8_BAR; }
        if constexpr (!Epi::AFTER_DRAIN) { E(acc, cur, wr, wc, fr, fq); S.done(cur); }
        if (!has_next) break;
#pragma unroll
        for (int a = 0; a < 2; ++a)
#pragma unroll
            for (int b = 0; b < 2; ++b)
#pragma unroll
                for (int m = 0; m < 4; ++m)
#pragma unroll
                    for (int n = 0; n < 2; ++n) acc[a][b][m][n] = (f32x4){0.f, 0.f, 0.f, 0.f};
        cur = nxt; cA = nA; cB = nB; ++ui;
        if constexpr (ALIGN_EPI) { if (wr == 1) PG8_BAR; }
    }
    PG8_WAIT_V(0);
    if constexpr (!ALIGN_EPI) { if (wr == 0) PG8_BAR; }
    PG8_BAR;
    if constexpr (Epi::AFTER_DRAIN) { E.fused(acc, cur, wr, wc, fr, fq, lds, wid, lane); S.done(cur); }
#undef PG8_SA
#undef PG8_SB
#undef PG8_STAGE
#undef PG8_LDA
#undef PG8_LDB
#undef PG8_MMA
#undef PG8_WAIT_V
#undef PG8_WAIT_L
#undef PG8_BAR
#undef PG8_SCHED
}
}
#define GAS __attribute__((address_space(1)))
#define LAS __attribute__((address_space(3)))
typedef unsigned short bf16;
typedef unsigned v4u __attribute__((ext_vector_type(4)));
typedef float f32x4 __attribute__((ext_vector_type(4)));
#define LDS_WAIT() asm volatile("s_waitcnt lgkmcnt(0)" ::: "memory")
__device__ __forceinline__ unsigned f2bf(float f) { unsigned u = __builtin_bit_cast(unsigned, f); return (u + 0x7fffu + ((u >> 16) & 1u)) >> 16; }
__device__ __forceinline__ unsigned pk2(float lo, float hi) { return f2bf(lo) | (f2bf(hi) << 16); }
__device__ __forceinline__ float bf2f(unsigned short b) { return __builtin_bit_cast(float, (unsigned)b << 16); }
__device__ __forceinline__ float wave_sum(float v) {
#pragma unroll
    for (int o = 1; o < 64; o <<= 1) v += __shfl_xor(v, o);
    return v;
}
__device__ __forceinline__ int grow(int b, int t) { return t < 128 ? MR + (t - 112) : b * 4096 + (t - 128); }

#define XB_TMO      128
#define XB_XCNT(j)  (256  + 64 * (j))
#define XB_XSUB(j)  (1280 + 64 * (j))
#define XB_XGEN(j)  (2304 + 64 * (j))
#define XB_TOP      3328
#define XB_TOPGEN   3392
#define XCD_BAR_WORDS 3456
#define XB_SPIN_CAP (1u << 27)
__device__ __forceinline__ unsigned xb_ld(unsigned* p)              { return __hip_atomic_load(p, __ATOMIC_RELAXED, __HIP_MEMORY_SCOPE_AGENT); }
__device__ __forceinline__ unsigned xb_add(unsigned* p, unsigned v) { return __hip_atomic_fetch_add(p, v, __ATOMIC_RELAXED, __HIP_MEMORY_SCOPE_AGENT); }
__device__ __forceinline__ unsigned xb_xcc_id() { return (unsigned)__builtin_amdgcn_s_getreg((3 << 11) | 20) & 0xFu; }
#define XB_SPIN(cond, bar) do { unsigned _sp = 0; while (cond) { __builtin_amdgcn_s_sleep(1); \
    if ((++_sp & 255u) == 0u) { if (xb_ld(&(bar)[XB_TMO])) break; if (_sp > XB_SPIN_CAP) { atomicAdd(&(bar)[XB_TMO], 1u); break; } } } } while (0)
struct XcdBarrier { unsigned* bar; unsigned x; volatile LAS unsigned* st; };
__device__ __forceinline__ XcdBarrier xcd_barrier_post(unsigned* bar, volatile LAS unsigned* st) {
    XcdBarrier b; b.bar = bar; b.x = xb_xcc_id(); b.st = st;
    if (threadIdx.x == 0) (void)xb_add(&bar[XB_XCNT(b.x)], 1u);
    return b;
}
__device__ __forceinline__ void xcd_barrier_complete(unsigned* bar, unsigned x, unsigned& nloc, unsigned& nx) {
    const unsigned G = gridDim.x * gridDim.y * gridDim.z;
    unsigned sum, cnt, mine, sp = 0u;
    for (;;) {
        sum = 0u; cnt = 0u; mine = 0u;
#pragma unroll
        for (unsigned j = 0; j < 16; ++j) { const unsigned c = xb_ld(&bar[XB_XCNT(j)]); sum += c; cnt += (c > 0u) ? 1u : 0u; mine = (j == x) ? c : mine; }
        if (sum == G) break;
        __builtin_amdgcn_s_sleep(1);
        if ((++sp & 255u) == 0u) { if (xb_ld(&bar[XB_TMO])) break; if (sp > XB_SPIN_CAP) { atomicAdd(&bar[XB_TMO], 1u); break; } }
    }
    nloc = mine > 0u ? mine : 1u; nx = cnt > 0u ? cnt : 1u;
}
__device__ __forceinline__ void xcd_barrier(const XcdBarrier& b) {
    asm volatile("s_waitcnt vmcnt(0)" ::: "memory");
    __syncthreads();
    int t0_ = threadIdx.x; asm volatile("" : "+v"(t0_));
    if (t0_ == 0) {
        unsigned* bar = b.bar;
        __builtin_amdgcn_s_waitcnt(0);
        unsigned nloc = b.st[0], nx = b.st[1];
        if (nloc == 0u) { xcd_barrier_complete(bar, b.x, nloc, nx); b.st[0] = nloc; b.st[1] = nx; }
        const unsigned old = xb_add(&bar[XB_XSUB(b.x)], 1u);
        const unsigned gen = old / nloc;
        if (old + 1u == (gen + 1u) * nloc) {
            __builtin_amdgcn_fence(__ATOMIC_RELEASE, "agent");
            asm volatile("s_waitcnt vmcnt(0)" ::: "memory");
            const unsigned og = xb_add(&bar[XB_TOP], 1u);
            const unsigned tg = og / nx;
            if (og + 1u == (tg + 1u) * nx) xb_add(&bar[XB_TOPGEN], 1u);
            else XB_SPIN(xb_ld(&bar[XB_TOPGEN]) == tg, bar);
            __builtin_amdgcn_fence(__ATOMIC_ACQUIRE, "agent");
            xb_add(&bar[XB_XGEN(b.x)], 1u);
            asm volatile("s_waitcnt vmcnt(0)" ::: "memory");
        } else {
            XB_SPIN(xb_ld(&bar[XB_XGEN(b.x)]) == gen, bar);
            __builtin_amdgcn_fence(__ATOMIC_ACQUIRE, "agent");
            asm volatile("s_waitcnt vmcnt(0)" ::: "memory");
        }
    }
    __syncthreads();
}

constexpr int NWAVES = 8;
constexpr int RING_BYTES = 131072, MISC_OFF = RING_BYTES + 320, LDS_BYTES = 147456;

__device__ __forceinline__ void transpose_item(const float* W, int K, int N, bf16* WT, int drow0, int scol0, int k0, const float* gain, LAS float* scr, int lane) {
    { const int c4 = (lane & 7) * 4, kr = lane >> 3; const float* wp = W + (size_t)(k0 + kr) * N + scol0 + c4; const size_t rstep = (size_t)8 * N;
      f32x4 v[8];
#pragma unroll
      for (int i = 0; i < 8; ++i) v[i] = *(const f32x4*)(wp + i * rstep);
#pragma unroll
      for (int i = 0; i < 8; ++i) { const int kk = 8 * i + kr; const float g = gain ? gain[k0 + kk] : 1.0f; LAS float* sp = scr + kk * 33 + c4; sp[0] = v[i][0] * g; sp[1] = v[i][1] * g; sp[2] = v[i][2] * g; sp[3] = v[i][3] * g; } }
    LDS_WAIT(); asm volatile("" ::: "memory");
    const int c = lane & 7;
#pragma unroll
    for (int j = 0; j < 4; ++j) { const int n = (lane >> 3) + 8 * j; const LAS float* s = scr + (8 * c) * 33 + n;
        v4u o; o.x = pk2(s[0 * 33], s[1 * 33]); o.y = pk2(s[2 * 33], s[3 * 33]); o.z = pk2(s[4 * 33], s[5 * 33]); o.w = pk2(s[6 * 33], s[7 * 33]);
        *(v4u*)(WT + (size_t)(drow0 + n) * K + k0 + 8 * c) = o; }
    LDS_WAIT(); asm volatile("" ::: "memory");
}
struct In { const float *x, *meta, *ffn1_norm, *ffn1_gu, *ffn1_dn, *mix_norm, *w_in, *ret_gn, *w_ret, *w_sb, *w_out, *ffn2_norm, *ffn2_gu, *ffn2_dn, *final_norm; };
__device__ __forceinline__ int gu_src(int g) { const int pn = g >> 3, q = g & 7; return q < 4 ? 128 * pn + 32 * q : 2816 + 128 * pn + 32 * (q - 4); }
__device__ __forceinline__ int in_src(int g) { const int pn = g >> 3, q = g & 7; if (pn >= 4) return 32 * g; const int base = pn < 2 ? 0 : 512, head = 4 * (pn & 1) + (q & 3); return base + 64 * head + 32 * (q >> 2); }
constexpr int CV_GU1 = 0, CV_GU2 = 2816, CV_DN1 = 5632, CV_DN2 = 7040, CV_IN = 8448, CV_RSO = 11776, CV_END = 13056;
__device__ __forceinline__ void convert_range(const In& in, int l, int it_lo, int it_hi, unsigned char* ws, LAS unsigned char* lds, int gw, int NGW, int wave, int lane_in) {
    int lane = lane_in; asm volatile("" : "+v"(lane));
    LAS float* scr = (LAS float*)(lds + wave * 16384);
    constexpr int I_GU = 16 * 176, I_DN = 44 * 32, I_IN = 16 * 208, I_RET = 16 * 32, I_SB = 8 * 32, I_OUT = 16 * 32;
#pragma unroll 1
    for (int it = it_lo + gw; it < it_hi; it += NGW) {
        int r = it; const float* W; const float* gain = nullptr; int K = DM, N = DM, ng = 32, kind = 0; size_t woff, doff;
        if (r < I_GU) { W = in.ffn1_gu; woff = (size_t)l * DM * 5632; N = 5632; ng = 176; kind = 1; gain = in.ffn1_norm + l * DM; doff = W_GU1; }
        else if ((r -= I_GU) < I_GU) { W = in.ffn2_gu; woff = (size_t)l * DM * 5632; N = 5632; ng = 176; kind = 1; gain = in.ffn2_norm + l * DM; doff = W_GU2; }
        else if ((r -= I_GU) < I_DN) { W = in.ffn1_dn; woff = (size_t)l * DFF * DM; K = DFF; doff = W_DN1; }
        else if ((r -= I_DN) < I_DN) { W = in.ffn2_dn; woff = (size_t)l * DFF * DM; K = DFF; doff = W_DN2; }
        else if ((r -= I_DN) < I_IN) { W = in.w_in; woff = (size_t)l * DM * DIN; N = DIN; ng = 208; kind = 2; gain = in.mix_norm + l * DM; doff = W_IN; }
        else if ((r -= I_IN) < I_RET) { W = in.w_ret; woff = (size_t)l * DM * DM; doff = W_RET; }
        else if ((r -= I_RET) < I_SB) { W = in.w_sb; woff = (size_t)l * 512 * DM; K = 512; doff = W_SB; }
        else { r -= I_SB; W = in.w_out; woff = (size_t)l * DM * DM; doff = W_OUT; }
        const int g = r % ng, kb = r / ng; const int sc = kind == 1 ? gu_src(g) : kind == 2 ? in_src(g) : 32 * g;
        transpose_item(W + woff, K, N, (bf16*)(ws + WS_W + doff), 32 * g, sc, 64 * kb, gain, scr, lane);
    }
}
__device__ __forceinline__ void init_rows(const In& in, float* out, unsigned char* ws, int gw, int NGW, int lane) {
    unsigned long long* ss = (unsigned long long*)(ws + WS_SS); float* hside = (float*)(ws + WS_HSIDE); bf16* HB = (bf16*)(ws + WS_HB);
    for (int m = gw; m < MR + 16; m += NGW) {
        f32x4 v[4]; float s = 0.f; float* hp; const f32x4* xr;
        if (m < MR) { xr = (const f32x4*)(in.x + (size_t)m * DM) + lane; hp = out + (size_t)m * DM; }
        else { xr = (const f32x4*)(in.meta + (size_t)(m - MR) * DM) + lane; hp = hside + (size_t)(m - MR) * DM; }
#pragma unroll
        for (int j = 0; j < 4; ++j) v[j] = xr[64 * j];
#pragma unroll
        for (int j = 0; j < 4; ++j) { s += (v[j].x * v[j].x + v[j].y * v[j].y) + (v[j].z * v[j].z + v[j].w * v[j].w); if (m >= MR) ((f32x4*)hp + lane)[64 * j] = v[j];
            ((unsigned long long*)(HB + (size_t)m * DM) + lane)[64 * j] = (unsigned long long)pk2(v[j].x, v[j].y) | ((unsigned long long)pk2(v[j].z, v[j].w) << 32); }
        s = wave_sum(s);
        if (lane == 0) ss[m] = (unsigned long long)(s * 1048576.0f + 0.5f);
    }
    const int gt = gw * 64 + lane, GT = NGW * 64;
    for (int i = gt; i < 6 * M; i += GT) ss[M + i] = 0ull;
    float* tab = (float*)(ws + WS_TAB);
    for (int i = gt; i < LSEQ * 32; i += GT) { const int t = i >> 5, d = i & 31;
        const float freq = __builtin_amdgcn_exp2f(-(float)d * (13.287712379549449f / 32.0f));
        const double rev = (double)(t - 112) * (double)freq * 0.15915494309189535; const float fr_ = (float)(rev - __builtin_rint(rev));
        tab[2 * i] = __builtin_amdgcn_cosf(fr_); tab[2 * i + 1] = __builtin_amdgcn_sinf(fr_); }
}
__device__ __forceinline__ void final_norm(const In& in, float* out, unsigned char* ws, int gw, int NGW, int lane) {
    const unsigned long long* ss = (const unsigned long long*)(ws + WS_SS) + 6 * M;
    for (int m = gw; m < MR; m += NGW) { const float r = __builtin_amdgcn_rsqf((float)ss[m] * (1.0f / (1024.0f * 1048576.0f)) + EPS); f32x4* hp = (f32x4*)(out + (size_t)m * DM) + lane; const f32x4* gp = (const f32x4*)in.final_norm + lane;
#pragma unroll
        for (int j = 0; j < 4; ++j) { f32x4 v = hp[64 * j]; const f32x4 g = gp[64 * j]; v = v * r * g; hp[64 * j] = v; } }
}

namespace sbk {
typedef short bf16x8 __attribute__((ext_vector_type(8)));
typedef float f32x16 __attribute__((ext_vector_type(16)));
typedef unsigned u32x2 __attribute__((ext_vector_type(2)));
typedef unsigned u32x4 __attribute__((ext_vector_type(4)));
constexpr int KSTR = 144, VSTR = 136, KBUF = 64 * KSTR, VBUF = 64 * VSTR, BUFB = KBUF + VBUF;
typedef float f32x2_t __attribute__((ext_vector_type(2))); typedef __bf16 bf16x2_t __attribute__((ext_vector_type(2)));
__device__ __forceinline__ unsigned cvtpk(float lo, float hi) { f32x2_t v = {lo, hi}; bf16x2_t b = __builtin_convertvector(v, bf16x2_t); return __builtin_bit_cast(unsigned, b); }

template <bool SPECIAL> __device__ __forceinline__ void sb_half(f32x16 (&o)[2], float& carry, const bf16x8 (&qf)[4], LAS const unsigned char* Kb, LAS const unsigned char* Vb,
                                                                int kh, int k0, int qpos, int r, int hi, float mh) {
    f32x16 p;
#pragma unroll
    for (int i = 0; i < 16; ++i) p[i] = 0.f;
    LAS const unsigned char* kp = Kb + (32 * kh + r) * KSTR + hi * 16;
#pragma unroll
    for (int s = 0; s < 4; ++s) { const bf16x8 kf = *(LAS const bf16x8*)(kp + 32 * s); p = __builtin_amdgcn_mfma_f32_32x32x16_bf16(kf, qf[s], p, 0, 0, 0); }
    float l[16], tz[16];
#pragma unroll
    for (int i = 0; i < 16; ++i) { const float z = fminf(p[i], 60.f); const float e = __builtin_amdgcn_exp2f(z); l[i] = __builtin_amdgcn_logf(1.0f + e); tz[i] = z - l[i]; }
    if (SPECIAL) {
#pragma unroll
        for (int i = 0; i < 16; ++i) { const int key = k0 + 8 * (i >> 2) + 4 * hi + (i & 3); const bool ok = (key < qpos) && (key >= 112); l[i] = ok ? l[i] : 0.f; tz[i] = ok ? tz[i] : -1e30f; }
    }
    float T[4], S[4], sfx[16];
#pragma unroll
    for (int g = 0; g < 4; ++g) { sfx[4 * g + 3] = 0.f; sfx[4 * g + 2] = l[4 * g + 3]; sfx[4 * g + 1] = sfx[4 * g + 2] + l[4 * g + 2]; sfx[4 * g] = sfx[4 * g + 1] + l[4 * g + 1]; T[g] = sfx[4 * g] + l[4 * g]; }
#pragma unroll
    for (int g = 0; g < 4; ++g) S[g] = T[g] + __shfl_xor(T[g], 32);
    float R[4]; R[3] = carry; R[2] = R[3] + S[3]; R[1] = R[2] + S[2]; R[0] = R[1] + S[1]; carry = R[0] + S[0];
    unsigned pw[8];
#pragma unroll
    for (int g = 0; g < 4; ++g) { const float off = R[g] + mh * (S[g] - T[g]); float a[4];
#pragma unroll
        for (int e = 0; e < 4; ++e) a[e] = __builtin_amdgcn_exp2f(tz[4 * g + e] - (off + sfx[4 * g + e]));
        pw[2 * g] = cvtpk(a[0], a[1]); pw[2 * g + 1] = cvtpk(a[2], a[3]); }
    const u32x4 pb0 = {pw[0], pw[1], pw[2], pw[3]}, pb1 = {pw[4], pw[5], pw[6], pw[7]};
#pragma unroll
    for (int dt = 0; dt < 2; ++dt) {
        LAS const unsigned char* vp = Vb + (32 * dt + r) * VSTR + (32 * kh + 4 * hi) * 2;
        const u32x2 a0 = *(LAS const u32x2*)(vp), a1 = *(LAS const u32x2*)(vp + 16), b0 = *(LAS const u32x2*)(vp + 32), b1 = *(LAS const u32x2*)(vp + 48);
        const u32x4 v0 = {a0.x, a0.y, a1.x, a1.y}, v1 = {b0.x, b0.y, b1.x, b1.y};
        o[dt] = __builtin_amdgcn_mfma_f32_32x32x16_bf16(__builtin_bit_cast(bf16x8, v0), __builtin_bit_cast(bf16x8, pb0), o[dt], 0, 0, 0);
        o[dt] = __builtin_amdgcn_mfma_f32_32x32x16_bf16(__builtin_bit_cast(bf16x8, v1), __builtin_bit_cast(bf16x8, pb1), o[dt], 0, 0, 0);
    }
}

__device__ __forceinline__ int krow(int b, int kt, int lkey) { return kt >= 2 ? b * 4096 + 64 * kt - 128 + lkey : MR + (lkey >= 48 ? lkey - 48 : 0); }
__device__ __forceinline__ void sb_unit(unsigned char* ws, LAS unsigned char* lds, int b, int h, int tq0, int nrows, int tid) {
    const int lane = tid & 63, wave = __builtin_amdgcn_readfirstlane(tid >> 6), r = lane & 31, hi = lane >> 5;
    const unsigned short* SQ = (const unsigned short*)(ws + WS_SQ); const unsigned short* SK = (const unsigned short*)(ws + WS_SK); const unsigned short* SV = (const unsigned short*)(ws + WS_SV);
    const bool metau = tq0 == 0; const bool wact = metau ? (wave == 3) : (32 * wave < nrows); const int qw = tq0 + 32 * wave; const int qpos = qw + r;
    const int qrow = metau ? MR + (qpos >= 112 && qpos < 128 ? qpos - 112 : 0) : b * 4096 + (tq0 - 128) + (wact ? 32 * wave : 0) + r;
    bf16x8 qf[4];
#pragma unroll
    for (int s = 0; s < 4; ++s) qf[s] = *(const bf16x8*)(SQ + (size_t)qrow * 512 + 64 * h + 16 * s + 8 * hi);
    f32x16 o[2];
#pragma unroll
    for (int i = 0; i < 16; ++i) { o[0][i] = 0.f; o[1][i] = 0.f; }
    float carry = 0.f; const float mh = hi == 0 ? 1.0f : 0.0f;
    const int kt_hi = (tq0 + nrows - 1) >> 6;
    const int lkey = tid >> 3, lch = tid & 7;
    constexpr int WIN = 7;
    LAS unsigned* flags = (LAS unsigned*)(lds + WIN * BUFB);
    bool wdone = !wact;
    int kt_top = kt_hi;
#pragma unroll 1
    for (;;) {
        const int nt = kt_top < WIN ? kt_top : WIN;
        u32x4 kreg[WIN], vreg[WIN];
#pragma unroll
        for (int sl = 0; sl < WIN; ++sl) if (sl < nt) { const size_t gr = (size_t)krow(b, kt_top - sl, lkey) * 512 + 64 * h + 8 * lch; kreg[sl] = *(const u32x4*)(SK + gr); vreg[sl] = *(const u32x4*)(SV + gr); }
        __syncthreads();
#pragma unroll
        for (int sl = 0; sl < WIN; ++sl) if (sl < nt) { LAS unsigned char* Kb = lds + sl * BUFB; LAS unsigned char* Vb = Kb + KBUF;
            *(LAS u32x4*)(Kb + lkey * KSTR + lch * 16) = kreg[sl];
            LAS unsigned short* vd = (LAS unsigned short*)(Vb + (8 * lch) * VSTR + lkey * 2); const unsigned* vw = (const unsigned*)&vreg[sl];
#pragma unroll
            for (int e = 0; e < 4; ++e) { vd[(2 * e) * (VSTR / 2)] = (unsigned short)(vw[e] & 0xffffu); vd[(2 * e + 1) * (VSTR / 2)] = (unsigned short)(vw[e] >> 16); } }
        __syncthreads();
        if (!wdone) {
#pragma unroll 1
            for (int sl = 0; sl < nt; ++sl) { const int kt = kt_top - sl; LAS unsigned char* Kb = lds + sl * BUFB; LAS unsigned char* Vb = Kb + KBUF;
                if (64 * kt > qw) continue;
#pragma unroll
                for (int kh = 1; kh >= 0; --kh) { const int k0 = 64 * kt + 32 * kh;
                    if (k0 <= qw && k0 >= 96) {
                        if (k0 == qw || k0 == 96) sb_half<true>(o, carry, qf, Kb, Vb, kh, k0, qpos, r, hi, mh);
                        else sb_half<false>(o, carry, qf, Kb, Vb, kh, k0, qpos, r, hi, mh);
                    } }
                if (__all(carry >= 150.f)) { wdone = true; break; }
            }
        }
        kt_top -= nt;
        if (kt_top < 1) break;
        if (lane == 0) flags[wave] = wdone ? 1u : 0u;
        __syncthreads();
        { const u32x4 f0 = *(LAS const u32x4*)(flags), f1 = *(LAS const u32x4*)(flags + 4);
          if ((f0.x & f0.y & f0.z & f0.w & f1.x & f1.y & f1.z & f1.w) != 0u) break; }
    }
    if (wact && (!metau || qpos >= 112)) { unsigned short* op = (unsigned short*)(ws + WS_SQ) + (size_t)qrow * 512 + 64 * h + 4 * hi;
#pragma unroll
        for (int dt = 0; dt < 2; ++dt)
#pragma unroll
            for (int g = 0; g < 4; ++g) { u32x2 w; w.x = cvtpk(o[dt][4 * g], o[dt][4 * g + 1]); w.y = cvtpk(o[dt][4 * g + 2], o[dt][4 * g + 3]); *(u32x2*)(op + 32 * dt + 8 * g) = w; } }
    __syncthreads();
}
}
namespace retk {
typedef short bf16x8 __attribute__((ext_vector_type(8)));
typedef float f32x16 __attribute__((ext_vector_type(16)));
typedef float f32x4 __attribute__((ext_vector_type(4)));
typedef float f32x2 __attribute__((ext_vector_type(2)));
typedef unsigned u32x2 __attribute__((ext_vector_type(2)));
typedef unsigned u32x4 __attribute__((ext_vector_type(4)));
constexpr int KSTR = 144, TSTR = 272;
constexpr int K_OFF = 0, KDT_OFF = 128 * KSTR, VT_OFF = KDT_OFF + 64 * TSTR, RT_OFF = VT_OFF + 128 * TSTR, GN_OFF = RT_OFF + 128 * KSTR, LDS_END = GN_OFF + 2048;
static_assert(LDS_END <= 131072, "retention LDS");
using sbk::cvtpk;
__device__ __forceinline__ int crow(int i, int hi) { return (i & 3) + 8 * (i >> 2) + 4 * hi; }
__device__ __forceinline__ float loggamma2(int h) { return __builtin_amdgcn_logf(1.0f - __builtin_amdgcn_exp2f(-5.0f - (float)h)); }
__device__ __forceinline__ void scatter_t(LAS unsigned char* base, int ch, int ls, const u32x4& v) {
    LAS unsigned short* d = (LAS unsigned short*)(base + (8 * ch) * TSTR + ls * 2); const unsigned* w = (const unsigned*)&v;
#pragma unroll
    for (int e = 0; e < 4; ++e) { d[(2 * e) * (TSTR / 2)] = (unsigned short)(w[e] & 0xffffu); d[(2 * e + 1) * (TSTR / 2)] = (unsigned short)(w[e] >> 16); }
}

__device__ __forceinline__ void kv_item(unsigned char* ws, LAS unsigned char* lds, int b, int h, int n, int tid) {
    const int lane = tid & 63, wave = __builtin_amdgcn_readfirstlane(tid >> 6), r = lane & 31, hi = lane >> 5, et = wave >> 1, dtl = wave & 1;
    const unsigned short* RK = (const unsigned short*)(ws + WS_RK); const unsigned short* RV = (const unsigned short*)(ws + WS_RV);
    const int ls = tid & 127, lc = tid >> 7; const int rowbase = n > 0 ? b * 4096 + 128 * (n - 1) : MR - 112;
    const float lg = loggamma2(h), kdec = __builtin_amdgcn_exp2f((float)(127 - ls) * lg);
    u32x4 kreg[2], vreg[4];
    const bool kvalid = n > 0 || ls >= 112;
#pragma unroll
    for (int i = 0; i < 2; ++i) kreg[i] = kvalid ? *(const u32x4*)(RK + (size_t)(rowbase + ls) * 512 + 64 * h + 8 * (lc + 4 * i)) : (u32x4){0u, 0u, 0u, 0u};
#pragma unroll
    for (int i = 0; i < 4; ++i) vreg[i] = kvalid ? *(const u32x4*)(RV + (size_t)(rowbase + ls) * 1024 + 128 * h + 8 * (lc + 4 * i)) : (u32x4){0u, 0u, 0u, 0u};
#pragma unroll
    for (int i = 0; i < 2; ++i) { const unsigned* kw = (const unsigned*)&kreg[i]; u32x4 kd;  unsigned* kdp = (unsigned*)&kd;
#pragma unroll
        for (int e = 0; e < 4; ++e) kdp[e] = cvtpk(__builtin_bit_cast(float, kw[e] << 16) * kdec, __builtin_bit_cast(float, kw[e] & 0xffff0000u) * kdec);
        scatter_t(lds + KDT_OFF, lc + 4 * i, ls, kd); }
#pragma unroll
    for (int i = 0; i < 4; ++i) scatter_t(lds + VT_OFF, lc + 4 * i, ls, vreg[i]);
    __syncthreads();
    f32x16 rs;
#pragma unroll
    for (int i = 0; i < 16; ++i) rs[i] = 0.f;
    { LAS const unsigned char* ap = lds + VT_OFF + (32 * et + r) * TSTR + hi * 16; LAS const unsigned char* bp = lds + KDT_OFF + (32 * dtl + r) * TSTR + hi * 16;
#pragma unroll
      for (int ks = 0; ks < 8; ++ks) rs = __builtin_amdgcn_mfma_f32_32x32x16_bf16(*(LAS const bf16x8*)(ap + 32 * ks), *(LAS const bf16x8*)(bp + 32 * ks), rs, 0, 0, 0); }
    u32x4 o0, o1; unsigned* p0 = (unsigned*)&o0; unsigned* p1 = (unsigned*)&o1;
#pragma unroll
    for (int e = 0; e < 4; ++e) { p0[e] = cvtpk(rs[2 * e], rs[2 * e + 1]); p1[e] = cvtpk(rs[8 + 2 * e], rs[8 + 2 * e + 1]); }
    u32x4* dst = (u32x4*)(ws + WS_KV + ((size_t)((b * 8 + h) * 33 + n) * 8 + wave) * 2048) + 2 * lane;
    dst[0] = o0; dst[1] = o1;
    __syncthreads();
}

__device__ __forceinline__ void out_item(unsigned char* ws, const float* ret_gn, LAS unsigned char* lds, int b, int h, int n, int tid) {
    const int lane = tid & 63, wave = __builtin_amdgcn_readfirstlane(tid >> 6), r = lane & 31, hi = lane >> 5;
    const int rb = wave & 3, dh = wave >> 2, et = wave >> 1, dtl = wave & 1;
    const unsigned short* RQ = (const unsigned short*)(ws + WS_RQ); const unsigned short* RK = (const unsigned short*)(ws + WS_RK); const unsigned short* RV = (const unsigned short*)(ws + WS_RV);
    unsigned short* RG = (unsigned short*)(ws + WS_RG);
    const float lg = loggamma2(h);
    const float cd = __builtin_amdgcn_exp2f(128.0f * lg), qdec = __builtin_amdgcn_exp2f((float)(32 * rb + r + 1) * lg);
    const int ls = tid & 127, lc = tid >> 7; const int rowbase = n > 0 ? b * 4096 + 128 * (n - 1) : MR - 112;
    u32x4 kreg[2], vreg[4]; bf16x8 qf[4];
    const bool kvalid = n > 0 || ls >= 112;
#pragma unroll
    for (int i = 0; i < 2; ++i) kreg[i] = kvalid ? *(const u32x4*)(RK + (size_t)(rowbase + ls) * 512 + 64 * h + 8 * (lc + 4 * i)) : (u32x4){0u, 0u, 0u, 0u};
#pragma unroll
    for (int i = 0; i < 4; ++i) vreg[i] = kvalid ? *(const u32x4*)(RV + (size_t)(rowbase + ls) * 1024 + 128 * h + 8 * (lc + 4 * i)) : (u32x4){0u, 0u, 0u, 0u};
    const bool qvalid = n > 0 || (32 * rb + r) >= 112;
#pragma unroll
    for (int s = 0; s < 4; ++s) qf[s] = qvalid ? *(const bf16x8*)(RQ + (size_t)(rowbase + 32 * rb + r) * 512 + 64 * h + 16 * s + 8 * hi) : (bf16x8){0, 0, 0, 0, 0, 0, 0, 0};
    unsigned short* gp = RG + (size_t)(rowbase + 32 * rb + r) * 1024 + 128 * h + 64 * dh + 4 * hi; const float* gnp = ret_gn + 128 * h + 64 * dh + 4 * hi;
    u32x2 rgv[8];
#pragma unroll
    for (int j = 0; j < 8; ++j) rgv[j] = qvalid ? *(const u32x2*)(gp + 32 * (j >> 2) + 8 * (j & 3)) : (u32x2){0u, 0u};
    f32x16 rs;
#pragma unroll
    for (int i = 0; i < 16; ++i) rs[i] = 0.f;
    { const u32x4* src = (const u32x4*)(ws + WS_KV + ((size_t)((b * 8 + h) * 33) * 8 + wave) * 2048) + 2 * lane;
#pragma unroll 8
      for (int m = 0; m < n; ++m) { const u32x4 a0 = src[(size_t)m * 1024], a1 = src[(size_t)m * 1024 + 1]; const unsigned* q0 = (const unsigned*)&a0; const unsigned* q1 = (const unsigned*)&a1;
#pragma unroll
          for (int e = 0; e < 4; ++e) { rs[2 * e] = rs[2 * e] * cd + __builtin_bit_cast(float, q0[e] << 16); rs[2 * e + 1] = rs[2 * e + 1] * cd + __builtin_bit_cast(float, q0[e] & 0xffff0000u);
              rs[8 + 2 * e] = rs[8 + 2 * e] * cd + __builtin_bit_cast(float, q1[e] << 16); rs[8 + 2 * e + 1] = rs[8 + 2 * e + 1] * cd + __builtin_bit_cast(float, q1[e] & 0xffff0000u); } } }
#pragma unroll
    for (int i = 0; i < 2; ++i) *(LAS u32x4*)(lds + K_OFF + ls * KSTR + (lc + 4 * i) * 16) = kreg[i];
#pragma unroll
    for (int i = 0; i < 4; ++i) scatter_t(lds + VT_OFF, lc + 4 * i, ls, vreg[i]);
#pragma unroll
    for (int i = 0; i < 16; i += 2) { const unsigned w = cvtpk(rs[i], rs[i + 1]);
        *(LAS unsigned short*)(lds + RT_OFF + (32 * et + crow(i, hi)) * KSTR + (32 * dtl + r) * 2) = (unsigned short)(w & 0xffffu);
        *(LAS unsigned short*)(lds + RT_OFF + (32 * et + crow(i + 1, hi)) * KSTR + (32 * dtl + r) * 2) = (unsigned short)(w >> 16); }
    __syncthreads();
    f32x16 o[2];
#pragma unroll
    for (int i = 0; i < 16; ++i) { o[0][i] = 0.f; o[1][i] = 0.f; }
#pragma unroll 1
    for (int sb = 0; sb <= rb; ++sb) {
        f32x16 p;
#pragma unroll
        for (int i = 0; i < 16; ++i) p[i] = 0.f;
        LAS const unsigned char* kp = lds + K_OFF + (32 * sb + r) * KSTR + hi * 16;
#pragma unroll
        for (int s = 0; s < 4; ++s) p = __builtin_amdgcn_mfma_f32_32x32x16_bf16(*(LAS const bf16x8*)(kp + 32 * s), qf[s], p, 0, 0, 0);
        unsigned pw[8]; const int dl0 = 32 * (rb - sb) + r;
#pragma unroll
        for (int i = 0; i < 16; i += 2) { const int d0 = dl0 - crow(i, hi), d1 = d0 - 1;
            const float a0 = d0 >= 0 ? p[i] * __builtin_amdgcn_exp2f((float)d0 * lg) : 0.f, a1 = d1 >= 0 ? p[i + 1] * __builtin_amdgcn_exp2f((float)d1 * lg) : 0.f;
            pw[i >> 1] = cvtpk(a0, a1); }
        const u32x4 pb0 = {pw[0], pw[1], pw[2], pw[3]}, pb1 = {pw[4], pw[5], pw[6], pw[7]};
#pragma unroll
        for (int e2 = 0; e2 < 2; ++e2) {
            LAS const unsigned char* vp = lds + VT_OFF + (32 * (2 * dh + e2) + r) * TSTR + (32 * sb + 4 * hi) * 2;
            const u32x2 a0 = *(LAS const u32x2*)(vp), a1 = *(LAS const u32x2*)(vp + 16), b0 = *(LAS const u32x2*)(vp + 32), b1 = *(LAS const u32x2*)(vp + 48);
            const u32x4 v0 = {a0.x, a0.y, a1.x, a1.y}, v1 = {b0.x, b0.y, b1.x, b1.y};
            o[e2] = __builtin_amdgcn_mfma_f32_32x32x16_bf16(__builtin_bit_cast(bf16x8, v0), __builtin_bit_cast(bf16x8, pb0), o[e2], 0, 0, 0);
            o[e2] = __builtin_amdgcn_mfma_f32_32x32x16_bf16(__builtin_bit_cast(bf16x8, v1), __builtin_bit_cast(bf16x8, pb1), o[e2], 0, 0, 0);
        }
    }
    if (n > 0) {
#pragma unroll
        for (int e2 = 0; e2 < 2; ++e2) { f32x16 x;
#pragma unroll
            for (int i = 0; i < 16; ++i) x[i] = 0.f;
            LAS const unsigned char* rp = lds + RT_OFF + (32 * (2 * dh + e2) + r) * KSTR + hi * 16;
#pragma unroll
            for (int s = 0; s < 4; ++s) x = __builtin_amdgcn_mfma_f32_32x32x16_bf16(*(LAS const bf16x8*)(rp + 32 * s), qf[s], x, 0, 0, 0);
#pragma unroll
            for (int i = 0; i < 16; ++i) o[e2][i] += x[i] * qdec; }
    }
    float s1 = 0.f, s2 = 0.f;
#pragma unroll
    for (int i = 0; i < 16; ++i) { s1 += o[0][i] + o[1][i]; s2 += o[0][i] * o[0][i] + o[1][i] * o[1][i]; }
    s1 += __shfl_xor(s1, 32); s2 += __shfl_xor(s2, 32);
    LAS f32x2* gnx = (LAS f32x2*)(lds + GN_OFF);
    if (hi == 0) gnx[dh * 128 + 32 * rb + r] = (f32x2){s1, s2};
    __syncthreads();
    { const f32x2 ot = gnx[(dh ^ 1) * 128 + 32 * rb + r]; s1 += ot.x; s2 += ot.y; }
    const float mu = s1 * (1.0f / 128.0f); const float rstd = __builtin_amdgcn_rsqf(fmaxf(s2 * (1.0f / 128.0f) - mu * mu, 0.f) + EPS);
#pragma unroll
    for (int e2 = 0; e2 < 2; ++e2)
#pragma unroll
        for (int g = 0; g < 4; ++g) { const f32x4 gv = *(const f32x4*)(gnp + 32 * e2 + 8 * g); const u32x2 rg = rgv[4 * e2 + g];
            const float y0 = (o[e2][4 * g] - mu) * rstd * gv[0] * __builtin_bit_cast(float, rg.x << 16), y1 = (o[e2][4 * g + 1] - mu) * rstd * gv[1] * __builtin_bit_cast(float, rg.x & 0xffff0000u);
            const float y2 = (o[e2][4 * g + 2] - mu) * rstd * gv[2] * __builtin_bit_cast(float, rg.y << 16), y3 = (o[e2][4 * g + 3] - mu) * rstd * gv[3] * __builtin_bit_cast(float, rg.y & 0xffff0000u);
            u32x2 w; w.x = cvtpk(y0, y1); w.y = cvtpk(y2, y3); if (qvalid) *(u32x2*)(gp + 32 * e2 + 8 * g) = w; }
    __syncthreads();
}

constexpr int N_SB = 512, N_KV = 32 * 33, N_ITEMS1 = N_SB + N_KV + 8, N_ITEMS2 = 32 * 32 + 8;
template <int PHASE> __device__ __forceinline__ void mixer_phase(unsigned char* ws, const float* ret_gn, LAS unsigned char* lds, volatile LAS unsigned* slot, unsigned* ctr, int tid_in) {
    int tid = tid_in; asm volatile("" : "+v"(tid));
    for (;;) {
        __syncthreads();
        if (tid == 0) slot[0] = __hip_atomic_fetch_add(ctr, 1u, __ATOMIC_RELAXED, __HIP_MEMORY_SCOPE_AGENT);
        __syncthreads();
        const int idx = (int)slot[0];
        if (PHASE == 1) {
            if (idx >= N_ITEMS1) break;
            if (idx < N_SB) { const int j = 15 - (idx >> 5), bh = idx & 31; sbk::sb_unit(ws, lds, bh >> 3, bh & 7, 128 + 256 * j, 256, tid); }
            else if (idx < N_SB + N_KV) { const int q = idx - N_SB, bh = q / 33, n = q - 33 * bh; kv_item(ws, lds, bh >> 3, bh & 7, n, tid); }
            else { const int hh = idx - N_SB - N_KV; sbk::sb_unit(ws, lds, 0, hh, 0, 128, tid); }
        } else {
            if (idx >= N_ITEMS2) break;
            if (idx < 1024) { const int n = 32 - idx / 32, bh = idx & 31; out_item(ws, ret_gn, lds, bh >> 3, bh & 7, n, tid); }
            else out_item(ws, ret_gn, lds, 0, idx - 1024, 0, tid);
        }
    }
}
}
namespace mini {
typedef short bf16x8 __attribute__((ext_vector_type(8)));
typedef float f32x4 __attribute__((ext_vector_type(4)));
typedef unsigned u32x2 __attribute__((ext_vector_type(2)));
using pg8::cvt_pk_bf16; using pg8::ss_t; using pg8::rowscale; using pg8::fsigmoid; using pg8::bflo; using pg8::bfhi;
template <int K> __device__ __forceinline__ f32x4 part(const unsigned short* A, const unsigned short* B, int wave, int lane) {
    constexpr int nks = K >> 8;
    const int rr = lane & 15, kg = lane >> 4;
    const unsigned short* ap = A + (size_t)rr * K + 32 * nks * wave + 8 * kg; const unsigned short* bp = B + (size_t)rr * K + 32 * nks * wave + 8 * kg;
    bf16x8 av[nks], bv[nks];
#pragma unroll
    for (int ks = 0; ks < nks; ++ks) { av[ks] = *(const bf16x8*)(ap + 32 * ks); bv[ks] = *(const bf16x8*)(bp + 32 * ks); }
    f32x4 acc = {0.f, 0.f, 0.f, 0.f};
#pragma unroll
    for (int ks = 0; ks < nks; ++ks) acc = __builtin_amdgcn_mfma_f32_16x16x32_bf16(bv[ks], av[ks], acc, 0, 0, 0);
    return acc;
}
template <bool TWO, int K0, int K1> __device__ __forceinline__ void task(LAS unsigned char* lds, const unsigned short* A0, const unsigned short* B0, const unsigned short* A1, const unsigned short* B1,
                                                          f32x4& r0, f32x4& r1, int wave, int lane) {
    LAS f32x4* red = (LAS f32x4*)lds;
    const f32x4 p0 = part<K0>(A0, B0, wave, lane); red[wave * 64 + lane] = p0;
    if (TWO) { const f32x4 p1 = part<K1>(A1, B1, wave, lane); red[512 + wave * 64 + lane] = p1; }
    __syncthreads();
    if (wave == 0) { f32x4 s = red[lane], t = {0.f, 0.f, 0.f, 0.f};
#pragma unroll
        for (int w = 1; w < 8; ++w) s = s + red[w * 64 + lane];
        if (TWO) { t = red[512 + lane];
#pragma unroll
            for (int w = 1; w < 8; ++w) t = t + red[512 + w * 64 + lane]; }
        r0 = s; r1 = t; }
}
__device__ __forceinline__ void st4(unsigned short* p, f32x4 v) { u32x2 w; w.x = cvt_pk_bf16(v[0], v[1]); w.y = cvt_pk_bf16(v[2], v[3]); *(u32x2*)p = w; }

__device__ __forceinline__ void gu(unsigned char* ws, LAS unsigned char* lds, const unsigned short* Wt, const ss_t* ss, int vcu, int G, int tid_in) {
    int tid = tid_in; asm volatile("" : "+v"(tid)); asm volatile("" : "+s"(vcu)); const int lane = tid & 63, wave = __builtin_amdgcn_readfirstlane(tid >> 6), row = lane & 15, cq = lane >> 4;
    const unsigned short* A = (const unsigned short*)(ws + WS_HB) + (size_t)MR * 1024;
    for (int t = vcu; t < 176; t += G) { const int f0 = 16 * t, wr = 256 * (f0 >> 7) + (f0 & 127); f32x4 a, b;
        task<true, 1024, 1024>(lds, A, Wt + (size_t)wr * 1024, A, Wt + (size_t)(wr + 128) * 1024, a, b, wave, lane);
        if (wave == 0) { const float r = rowscale(ss, MR + row); f32x4 o;
#pragma unroll
            for (int e = 0; e < 4; ++e) { const float x = a[e] * r, y = b[e] * r; o[e] = x * fsigmoid(x) * y; }
            st4((unsigned short*)(ws + WS_ACT) + (size_t)(MR + row) * 2816 + f0 + 4 * cq, o); }
        __syncthreads(); }
}
template <int K> __device__ __forceinline__ void resid(unsigned char* ws, LAS unsigned char* lds, const unsigned short* A, const unsigned short* Wt, ss_t* ssn, float s, int vcu, int G, int tid_in) {
    int tid = tid_in; asm volatile("" : "+v"(tid)); asm volatile("" : "+s"(vcu)); const int lane = tid & 63, wave = __builtin_amdgcn_readfirstlane(tid >> 6), row = lane & 15, cq = lane >> 4;
    for (int t = vcu; t < 64; t += G) { f32x4 a, b;
        task<false, K, 256>(lds, A + (size_t)MR * K, Wt + (size_t)(16 * t) * K, nullptr, nullptr, a, b, wave, lane);
        if (wave == 0) { float* hp = (float*)(ws + WS_HSIDE) + (size_t)row * 1024 + 16 * t + 4 * cq; f32x4 v = *(const f32x4*)hp; v = v + a * s; *(f32x4*)hp = v;
            st4((unsigned short*)(ws + WS_HB) + (size_t)(MR + row) * 1024 + 16 * t + 4 * cq, v);
            float sq = (v[0] * v[0] + v[1] * v[1]) + (v[2] * v[2] + v[3] * v[3]); sq += __shfl_xor(sq, 16); sq += __shfl_xor(sq, 32);
            if (cq == 0) atomicAdd(ssn + MR + row, (ss_t)(sq * 1048576.0f + 0.5f)); }
        __syncthreads(); }
}
__device__ __forceinline__ void inproj(unsigned char* ws, LAS unsigned char* lds, const unsigned short* Wt, const ss_t* ss, bool first, int vcu, int G, int tid_in) {
    int tid = tid_in; asm volatile("" : "+v"(tid)); asm volatile("" : "+s"(vcu)); const int lane = tid & 63, wave = __builtin_amdgcn_readfirstlane(tid >> 6), row = lane & 15, cq = lane >> 4;
    const unsigned short* A = (const unsigned short*)(ws + WS_HB) + (size_t)MR * 1024;
    const int nrot = first ? 32 : 0, c_lo = first ? 1024 : 4608, nplain = first ? 224 : 128;
    for (int t = vcu; t < nrot + nplain; t += G) { f32x4 a, b;
        if (t < nrot) { const int qk = t >> 4, head = (t >> 1) & 7, d0 = 16 * (t & 1); const int wr = 256 * (2 * qk + (head >> 2)) + 32 * (head & 3) + d0;
            task<true, 1024, 1024>(lds, A, Wt + (size_t)wr * 1024, A, Wt + (size_t)(wr + 128) * 1024, a, b, wave, lane);
            if (wave == 0) { const float r = rowscale(ss, MR + row) * (qk ? 0.125f : 1.0f); const int d = d0 + 4 * cq; const float* tp = (const float*)(ws + WS_TAB) + ((size_t)(112 + row) * 32 + d) * 2; f32x4 o1, o2;
#pragma unroll
                for (int e = 0; e < 4; ++e) { const float c = tp[2 * e], s = tp[2 * e + 1], t1 = a[e] * r, t2 = b[e] * r; o1[e] = t1 * c - t2 * s; o2[e] = t1 * s + t2 * c; }
                unsigned short* op = (unsigned short*)(ws + (qk ? WS_RK : WS_RQ)) + (size_t)(MR + row) * 512 + 64 * head + d; st4(op, o1); st4(op + 32, o2); }
        } else { const int c0 = c_lo + 16 * (t - nrot);
            task<false, 1024, 256>(lds, A, Wt + (size_t)c0 * 1024, nullptr, nullptr, a, b, wave, lane);
            if (wave == 0) { size_t off; int pitch, cb, act; float sc = 1.0f;
                if (c0 < 2048) { off = WS_RV; pitch = 1024; cb = 1024; act = 0; } else if (c0 < 3072) { off = WS_RG; pitch = 1024; cb = 2048; act = 1; }
                else if (c0 < 3584) { off = WS_SQ; pitch = 512; cb = 3072; act = 0; sc = SBC2; } else if (c0 < 4096) { off = WS_SK; pitch = 512; cb = 3584; act = 0; }
                else if (c0 < 4608) { off = WS_SV; pitch = 512; cb = 4096; act = 0; } else if (c0 < 5632) { off = WS_GA; pitch = 1024; cb = 4608; act = 2; } else { off = WS_GB; pitch = 1024; cb = 5632; act = 2; }
                const float r = rowscale(ss, MR + row) * sc; f32x4 o;
#pragma unroll
                for (int e = 0; e < 4; ++e) { float v = a[e] * r; if (act == 1) v = v * fsigmoid(v); else if (act == 2) v = fsigmoid(v); o[e] = v; }
                st4((unsigned short*)(ws + off) + (size_t)(MR + row) * pitch + (c0 - cb) + 4 * cq, o); }
        }
        __syncthreads(); }
}
__device__ __forceinline__ void proj(unsigned char* ws, LAS unsigned char* lds, const unsigned short* Wret, const unsigned short* Wsb, int vcu, int G, int tid_in) {
    int tid = tid_in; asm volatile("" : "+v"(tid)); asm volatile("" : "+s"(vcu)); const int lane = tid & 63, wave = __builtin_amdgcn_readfirstlane(tid >> 6), row = lane & 15, cq = lane >> 4;
    for (int t = vcu; t < 64; t += G) { f32x4 a, b;
        task<true, 1024, 512>(lds, (const unsigned short*)(ws + WS_RG) + (size_t)MR * 1024, Wret + (size_t)(16 * t) * 1024, (const unsigned short*)(ws + WS_SQ) + (size_t)MR * 512, Wsb + (size_t)(16 * t) * 512, a, b, wave, lane);
        if (wave == 0) { const size_t o = (size_t)(MR + row) * 1024 + 16 * t + 4 * cq; const u32x2 ga = *(const u32x2*)((const unsigned short*)(ws + WS_GA) + o), gb = *(const u32x2*)((const unsigned short*)(ws + WS_GB) + o);
            f32x4 y; y[0] = bflo(ga.x) * a[0] + bflo(gb.x) * b[0]; y[1] = bfhi(ga.x) * a[1] + bfhi(gb.x) * b[1]; y[2] = bflo(ga.y) * a[2] + bflo(gb.y) * b[2]; y[3] = bfhi(ga.y) * a[3] + bfhi(gb.y) * b[3];
            st4((unsigned short*)(ws + WS_Y) + o, y); }
        __syncthreads(); }
}
}
#ifndef PHMASK
#define PHMASK 0xFFFF
#endif
struct Args { In in; float* out; unsigned char* ws; int ph_lo, ph_hi; };
__global__ void __launch_bounds__(NWAVES * 64, 2) fwd_mega(Args args) {
    extern __shared__ __attribute__((aligned(16))) unsigned char lds_raw[];
    LAS unsigned char* lds = (LAS unsigned char*)lds_raw;
    volatile LAS unsigned* MISC = (volatile LAS unsigned*)(lds + MISC_OFF);
    const int tid = threadIdx.x, lane = tid & 63, wave = __builtin_amdgcn_readfirstlane(tid >> 6);
    const int G = gridDim.x; const int bx = blockIdx.x; const int vcu = (G % 8 == 0) ? (bx % 8) * (G / 8) + bx / 8 : bx;
    for (int u = tid; u < 64; u += NWAVES * 64) MISC[u] = 0u;
    __syncthreads();
    unsigned char* ws = args.ws; const In& in = args.in;
    XcdBarrier bar = xcd_barrier_post((unsigned*)(ws + WS_CTL) + CW_BAR, MISC + 8);
    const int gw = vcu * NWAVES + wave, NGW = G * NWAVES;
    pg8::ss_t* ssb = (pg8::ss_t*)(ws + WS_SS);
    pg8::bf16_t* HB = (pg8::bf16_t*)(ws + WS_HB);
    float* hside = (float*)(ws + WS_HSIDE);
#define WPTR(off) ((const pg8::bf16_t*)(ws + WS_W + (off)))
#define GRID_BAR() xcd_barrier(bar)

    convert_range(in, 0, CV_GU1, CV_GU2, ws, lds, gw, NGW, wave, lane);
    init_rows(in, args.out, ws, gw, NGW, lane);
    if (args.ph_lo == 0x7ead) cg::this_grid().sync(); else GRID_BAR();

#pragma unroll
    for (int l = 0; l < 2; ++l) {
        const pg8::ss_t* ss_a = ssb + (size_t)(3 * l) * M; pg8::ss_t* ss_b = ssb + (size_t)(3 * l + 1) * M; pg8::ss_t* ss_c = ssb + (size_t)(3 * l + 2) * M; pg8::ss_t* ss_d = ssb + (size_t)(3 * l + 3) * M;
        #if PHMASK & 1
        mini::gu(ws, lds, (const unsigned short*)WPTR(W_GU1), ss_a, vcu, G, tid);
        { pg8::Gemm g{HB, WPTR(W_GU1), MR, 2 * DFF, DM}; pg8::StaticOrder S; S.init(MR, 2 * DFF, G, bx);
          pg8::EpiSwiGLU E{(pg8::bf16_t*)(ws + WS_ACT), ss_a};
          pg8::gemm_phase<pg8::EpiSwiGLU, pg8::StaticOrder, true, true>(lds, g, S, E); }
          if (G == 256) { int bxs = bx; asm volatile("" : "+s"(bxs)); const int sgw = (bxs - 128) * NWAVES + wave; if (bxs >= 128) {        convert_range(in, l, CV_DN1, CV_DN2, ws, lds, sgw, 1024, wave, lane); convert_range(in, l, CV_IN, CV_RSO, ws, lds, sgw, 1024, wave, lane); } }
          else { convert_range(in, l, CV_DN1, CV_DN2, ws, lds, gw, NGW, wave, lane); convert_range(in, l, CV_IN, CV_RSO, ws, lds, gw, NGW, wave, lane); }

#endif
        GRID_BAR();
        #if PHMASK & 2
        mini::resid<DFF>(ws, lds, (const unsigned short*)(ws + WS_ACT), (const unsigned short*)WPTR(W_DN1), ss_b, 0.5f, vcu, G, tid);
        { pg8::Gemm g{(const pg8::bf16_t*)(ws + WS_ACT), WPTR(W_DN1), MR, DM, DFF}; pg8::StaticOrder S; S.init(MR, DM, G, bx);
          pg8::EpiResid E{l == 0 ? in.x : (const float*)args.out, args.out, HB, ss_b, 0.5f};
          pg8::gemm_phase<pg8::EpiResid, pg8::StaticOrder, true, true>(lds, g, S, E); }

#endif
        GRID_BAR();
        #if PHMASK & 4
        mini::inproj(ws, lds, (const unsigned short*)WPTR(W_IN), ss_b, true, vcu, G, tid);
        { pg8::Gemm g{HB, WPTR(W_IN), MR, 4608, DM}; pg8::StaticOrder S; S.init(MR, 4608, G, bx);
          pg8::EpiIn E{ws, ss_b, 0};
          pg8::gemm_phase<pg8::EpiIn, pg8::StaticOrder, true, true>(lds, g, S, E); }
          if (G == 256) { int bxs = bx; asm volatile("" : "+s"(bxs)); const int sgw = (bxs - 128) * NWAVES + wave; if (bxs >= 128) {        convert_range(in, l, CV_RSO, CV_END, ws, lds, sgw, 1024, wave, lane); convert_range(in, l, CV_GU2, CV_DN1, ws, lds, sgw, 1024, wave, lane); } }
          else { convert_range(in, l, CV_RSO, CV_END, ws, lds, gw, NGW, wave, lane); convert_range(in, l, CV_GU2, CV_DN1, ws, lds, gw, NGW, wave, lane); }

#endif
        GRID_BAR();
        #if PHMASK & 8
        retk::mixer_phase<1>(ws, in.ret_gn + l * 1024, lds, MISC + 16, (unsigned*)(ws + WS_CTL) + CW_Q + 128 * l, tid);
        GRID_BAR();
        retk::mixer_phase<2>(ws, in.ret_gn + l * 1024, lds, MISC + 16, (unsigned*)(ws + WS_CTL) + CW_Q + 128 * l + 64, tid);

#endif
        GRID_BAR();
        #if PHMASK & 16
        mini::inproj(ws, lds, (const unsigned short*)WPTR(W_IN), ss_b, false, vcu, G, tid);
        { pg8::Gemm g{HB, WPTR(W_IN) + (size_t)4608 * DM, MR, 2048, DM}; pg8::StaticOrder S; S.init(MR, 2048, G, bx);
          pg8::EpiIn E{ws, ss_b, 18};
          pg8::gemm_phase<pg8::EpiIn, pg8::StaticOrder, true, true>(lds, g, S, E); }

#endif
        GRID_BAR();
        #if PHMASK & 32
        mini::proj(ws, lds, (const unsigned short*)WPTR(W_RET), (const unsigned short*)WPTR(W_SB), vcu, G, tid);
        { pg8::Gemm g{(const pg8::bf16_t*)(ws + WS_RG), WPTR(W_RET), MR, DM, DM}; pg8::StaticOrder S; S.init(MR, DM, G, bx);
          pg8::EpiProj<true> E{(const pg8::bf16_t*)(ws + WS_GA), (pg8::bf16_t*)(ws + WS_Y)};
          pg8::gemm_phase<pg8::EpiProj<true>, pg8::StaticOrder, true, true>(lds, g, S, E); }
        asm volatile("s_waitcnt vmcnt(0)" ::: "memory"); __syncthreads();
        { pg8::Gemm g{(const pg8::bf16_t*)(ws + WS_SQ), WPTR(W_SB), MR, DM, 512}; pg8::StaticOrder S; S.init(MR, DM, G, bx);
          pg8::EpiProj<false> E{(const pg8::bf16_t*)(ws + WS_GB), (pg8::bf16_t*)(ws + WS_Y)};
          pg8::gemm_phase<pg8::EpiProj<false>, pg8::StaticOrder, true, true>(lds, g, S, E); }

#endif
        GRID_BAR();
        #if PHMASK & 64
        mini::resid<DM>(ws, lds, (const unsigned short*)(ws + WS_Y), (const unsigned short*)WPTR(W_OUT), ss_c, 1.0f, vcu, G, tid);
        { pg8::Gemm g{(const pg8::bf16_t*)(ws + WS_Y), WPTR(W_OUT), MR, DM, DM}; pg8::StaticOrder S; S.init(MR, DM, G, bx);
          pg8::EpiResid E{args.out, args.out, HB, ss_c, 1.0f};
          pg8::gemm_phase<pg8::EpiResid, pg8::StaticOrder, true, true>(lds, g, S, E); }

#endif
        GRID_BAR();
        #if PHMASK & 128
        mini::gu(ws, lds, (const unsigned short*)WPTR(W_GU2), ss_c, vcu, G, tid);
        { pg8::Gemm g{HB, WPTR(W_GU2), MR, 2 * DFF, DM}; pg8::StaticOrder S; S.init(MR, 2 * DFF, G, bx);
          pg8::EpiSwiGLU E{(pg8::bf16_t*)(ws + WS_ACT), ss_c};
          pg8::gemm_phase<pg8::EpiSwiGLU, pg8::StaticOrder, true, true>(lds, g, S, E); }
          if (G == 256) { int bxs = bx; asm volatile("" : "+s"(bxs)); const int sgw = (bxs - 128) * NWAVES + wave; if (bxs >= 128) {        convert_range(in, l, CV_DN2, CV_IN, ws, lds, sgw, 1024, wave, lane); if (l == 0) convert_range(in, 1, CV_GU1, CV_GU2, ws, lds, sgw, 1024, wave, lane); } }
          else { convert_range(in, l, CV_DN2, CV_IN, ws, lds, gw, NGW, wave, lane); if (l == 0) convert_range(in, 1, CV_GU1, CV_GU2, ws, lds, gw, NGW, wave, lane); }

#endif
        GRID_BAR();
        #if PHMASK & 256
        mini::resid<DFF>(ws, lds, (const unsigned short*)(ws + WS_ACT), (const unsigned short*)WPTR(W_DN2), ss_d, 0.5f, vcu, G, tid);
        { pg8::Gemm g{(const pg8::bf16_t*)(ws + WS_ACT), WPTR(W_DN2), MR, DM, DFF}; pg8::StaticOrder S; S.init(MR, DM, G, bx);
          pg8::EpiResid E{args.out, args.out, HB, ss_d, 0.5f};
          pg8::gemm_phase<pg8::EpiResid, pg8::StaticOrder, true, true>(lds, g, S, E); }

#endif
        GRID_BAR();
    }
    final_norm(in, args.out, ws, gw, NGW, lane);
}

extern "C" void kernel_launch(void* const* d_in, const int* in_sizes, int n_in, void* d_out, int out_size, void* d_ws, size_t ws_size, hipStream_t stream) {
    static int grid = 0;
    if (grid == 0) {
        int dev = 0, cus = 0, per_cu = 0;
        if (n_in != 15 || out_size != MR * DM || ws_size < 256 * MiB) { fprintf(stderr, "kernel_launch: unexpected shapes n_in %d out %d ws %zu (need %zu)\n", n_in, out_size, ws_size, (size_t)WS_END); grid = -1; return; }
        (void)hipGetDevice(&dev); (void)hipDeviceGetAttribute(&cus, hipDeviceAttributeMultiprocessorCount, dev);
        (void)hipFuncSetAttribute((const void*)fwd_mega, hipFuncAttributeMaxDynamicSharedMemorySize, LDS_BYTES);
        (void)hipOccupancyMaxActiveBlocksPerMultiprocessor(&per_cu, (const void*)fwd_mega, NWAVES * 64, LDS_BYTES);
        if (per_cu < 1) per_cu = 1;
        grid = cus * per_cu;
    }
    if (grid < 0) return;
    (void)hipMemsetAsync((char*)d_ws + WS_CTL, 0, CTL_ZERO_BYTES, stream);
    Args a{};
    const float** ip = (const float**)&a.in;
    for (int i = 0; i < 15; ++i) ip[i] = (const float*)d_in[i];
    a.out = (float*)d_out; a.ws = (unsigned char*)d_ws; a.ph_lo = 0; a.ph_hi = 0;
    void* kargs[] = {&a};
    hipError_t e = hipLaunchCooperativeKernel((const void*)fwd_mega, dim3(grid), dim3(NWAVES * 64), kargs, LDS_BYTES, stream);
    if (e != hipSuccess) fprintf(stderr, "kernel_launch: cooperative launch failed: %s (grid %d)\n", hipGetErrorString(e), grid);
}
```

```cpp
#include <hip/hip_runtime.h>
#include <hip/hip_cooperative_groups.h>
#include <cstdio>
#include <cstdint>
namespace cg = cooperative_groups;

constexpr int DM = 1024, NBATCH = 4, SEQ = 4096, LSEQ = 4224, DFF = 2816, DIN = 6656;
constexpr int MR = NBATCH * SEQ;
constexpr int MX = NBATCH * 128;
constexpr int M = MR + MX;
constexpr float EPS = 1e-6f;
constexpr float LOG2E = 1.4426950408889634f;
constexpr float SBC2 = 0.125f * LOG2E;

constexpr size_t MiB = 1u << 20;
constexpr size_t WS_CTL = 0, CTL_ZERO_BYTES = 1 * MiB;
constexpr size_t WS_TAB = 1 * MiB;
constexpr size_t WS_SS = 3 * MiB;
constexpr size_t WS_HSIDE = 4 * MiB;
constexpr size_t WS_W = 6 * MiB;
constexpr size_t W_GU1 = 0, W_DN1 = W_GU1 + (size_t)2 * DFF * DM * 2, W_IN = W_DN1 + (size_t)DM * DFF * 2, W_RET = W_IN + (size_t)DIN * DM * 2,
                 W_SB = W_RET + (size_t)DM * DM * 2, W_OUT = W_SB + (size_t)DM * 512 * 2, W_GU2 = W_OUT + (size_t)DM * DM * 2, W_DN2 = W_GU2 + (size_t)2 * DFF * DM * 2,
                 W_END = W_DN2 + (size_t)DM * DFF * 2;
static_assert(W_END <= 52 * MiB, "weights");
constexpr size_t WS_HB = 58 * MiB;
constexpr size_t WS_RP = 91 * MiB;
constexpr size_t SZ512 = (size_t)M * 512 * 2, SZ1024 = (size_t)M * 1024 * 2;
constexpr size_t WS_RQ = WS_RP, WS_RK = WS_RQ + SZ512, WS_RV = WS_RK + SZ512, WS_RG = WS_RV + SZ1024, WS_SQ = WS_RG + SZ1024, WS_SK = WS_SQ + SZ512, WS_SV = WS_SK + SZ512, WS_END = WS_SV + SZ512;
constexpr size_t WS_KV = WS_END;
static_assert(WS_KV + (size_t)32 * 33 * 16384 <= 256 * MiB, "kv");
constexpr size_t WS_ACT = WS_RP;
constexpr size_t WS_GA = WS_RQ, WS_GB = WS_RV, WS_Y = WS_SK;
static_assert(WS_END <= 256 * MiB && (size_t)M * DFF * 2 <= WS_END - WS_RP, "ws map");
constexpr int CW_BAR = 4096, CW_Q = 16384;

namespace pg8 {
#define PG8_LAS __attribute__((address_space(3)))
typedef unsigned short bf16_t;
typedef short bf16x8 __attribute__((ext_vector_type(8)));
typedef float f32x4 __attribute__((ext_vector_type(4)));
typedef unsigned u32x4 __attribute__((ext_vector_type(4)));
constexpr int BM = 256, BK = 64, HALF = 128, HTB = HALF * BK * 2  , STAGE_BYTES = 8 * HTB, NXCD = 8, WGM = 8;

__host__ __device__ __forceinline__ int lds_byte(int r, int c) { const int st = (r >> 4) * 2 + (c >> 5), rr = r & 15, cc = c & 31, ob = rr * 64 + cc * 2; return st * 1024 + (ob ^ (((ob >> 9) & 1) << 5)); }
__host__ __device__ __forceinline__ void stage_rc(int b, int& R, int& C) { const int st = b / 1024, sb = b % 1024, swz = sb ^ (((sb >> 9) & 1) << 5); R = (st >> 1) * 16 + swz / 64; C = (st & 1) * 32 + (swz % 64) / 2; }
__host__ __device__ __forceinline__ int perm32(int rho) { const int n = rho >> 4, i = rho & 15; return 8 * (i >> 2) + 4 * n + (i & 3); }

struct Unit { int pm, pn; };
struct Gemm { const bf16_t* A; const bf16_t* Bt; int M, N, K; };

struct StaticOrder {
    int nM, nN, nwg, G, c;
    __host__ __device__ void init(int M, int N, int G_, int c_) { nM = M / BM; nN = N / BM; nwg = nM * nN; G = G_; c = c_; }
    __host__ __device__ bool next(int i, Unit& u) const {
        const long L = (long)i * G + c; if (L >= nwg) return false;
        int wgid = (int)L; { const int q = nwg / NXCD, r = nwg % NXCD, xcd = wgid % NXCD, off = wgid / NXCD; wgid = (xcd < r ? xcd * (q + 1) : r * (q + 1) + (xcd - r) * q) + off; }
        const int nig = WGM * nN, gid = wgid / nig, fm = gid * WGM, gsz = (nM - fm) < WGM ? (nM - fm) : WGM;
        u.pm = fm + ((wgid % nig) % gsz); u.pn = (wgid % nig) / gsz; return true;
    }
    __device__ __forceinline__ void a_ready(const Unit&) const {}
    __device__ __forceinline__ void done(const Unit&) const {}
};

typedef float f32x2c_t __attribute__((ext_vector_type(2))); typedef __bf16 bf16x2c_t __attribute__((ext_vector_type(2)));
__device__ __forceinline__ unsigned cvt_pk_bf16(float lo, float hi) { f32x2c_t v = {lo, hi}; bf16x2c_t b = __builtin_convertvector(v, bf16x2c_t); return __builtin_bit_cast(unsigned, b); }
typedef float f32x2 __attribute__((ext_vector_type(2)));
typedef unsigned u32x2 __attribute__((ext_vector_type(2)));
__device__ __forceinline__ float bf2f(unsigned short b) { return __builtin_bit_cast(float, (unsigned)b << 16); }
__device__ __forceinline__ float bflo(unsigned w) { return __builtin_bit_cast(float, w << 16); }
__device__ __forceinline__ float bfhi(unsigned w) { return __builtin_bit_cast(float, w & 0xffff0000u); }
__device__ __forceinline__ float fsigmoid(float x) { return __builtin_amdgcn_rcpf(1.0f + __builtin_amdgcn_exp2f(-x * 1.4426950408889634f)); }
typedef unsigned long long ss_t;
__device__ __forceinline__ float rowscale(const ss_t* ss, int row) { return __builtin_amdgcn_rsqf((float)ss[row] * (1.0f / (1024.0f * 1048576.0f)) + 1e-6f); }

struct EpiSwiGLU {
    static constexpr bool PERM = true, AFTER_DRAIN = false;
    bf16_t* O; const ss_t* ss;
    __device__ __forceinline__ void operator()(const f32x4 (&acc)[2][2][4][2], const Unit& u, int wr, int wc, int fr, int fq) const {
        const int row0 = u.pm * BM + wr * 64 + fr; const int col0 = u.pn * 128 + wc * 32 + 8 * fq;
#pragma unroll
        for (int ai = 0; ai < 2; ++ai)
#pragma unroll
            for (int m = 0; m < 4; ++m) { const int row = row0 + ai * HALF + m * 16; const float r = rowscale(ss, row);
                u32x4 w; unsigned* wp = (unsigned*)&w;
#pragma unroll
                for (int n = 0; n < 2; ++n) { float o[4];
#pragma unroll
                    for (int e = 0; e < 4; ++e) { const float a = acc[ai][0][m][n][e] * r, b = acc[ai][1][m][n][e] * r; o[e] = a * fsigmoid(a) * b; }
                    wp[2 * n] = cvt_pk_bf16(o[0], o[1]); wp[2 * n + 1] = cvt_pk_bf16(o[2], o[3]); }
                *(u32x4*)(O + (size_t)row * 2816 + col0) = w; }
    }
};
struct EpiResid {
    static constexpr bool PERM = false, AFTER_DRAIN = false;
    const float* Hsrc; float* Hmain; bf16_t* HB; ss_t* ssn; float s;
    __device__ __forceinline__ void operator()(const f32x4 (&acc)[2][2][4][2], const Unit& u, int wr, int wc, int fr, int fq) const {
        const int row0 = u.pm * BM + wr * 64 + fr; const int col0 = u.pn * BM + wc * 32 + 4 * fq;
#pragma unroll
        for (int ai = 0; ai < 2; ++ai)
#pragma unroll
            for (int m = 0; m < 4; ++m) { const int row = row0 + ai * HALF + m * 16; float* hp = Hmain + (size_t)row * 1024 + col0; const float* sp = Hsrc + (size_t)row * 1024 + col0; bf16_t* bp = HB + (size_t)row * 1024 + col0; float sq = 0.f;
#pragma unroll
                for (int bj = 0; bj < 2; ++bj)
#pragma unroll
                    for (int n = 0; n < 2; ++n) { f32x4 v = *(const f32x4*)(sp + bj * HALF + n * 16); v = v + acc[ai][bj][m][n] * s; *(f32x4*)(hp + bj * HALF + n * 16) = v;
                        sq += (v[0] * v[0] + v[1] * v[1]) + (v[2] * v[2] + v[3] * v[3]);
                        u32x2 w; w.x = cvt_pk_bf16(v[0], v[1]); w.y = cvt_pk_bf16(v[2], v[3]); *(u32x2*)(bp + bj * HALF + n * 16) = w; }
                sq += __shfl_xor(sq, 16); sq += __shfl_xor(sq, 32);
                if (fq == 0) atomicAdd(ssn + row, (ss_t)(sq * 1048576.0f + 0.5f)); asm volatile("" ::: "memory"); }
    }
};
struct EpiIn {
    static constexpr bool PERM = true, AFTER_DRAIN = false;
    unsigned char* ws; const ss_t* ss; int pn_off;
    __device__ __forceinline__ void operator()(const f32x4 (&acc)[2][2][4][2], const Unit& u, int wr, int wc, int fr, int fq) const {
        const int gpn = u.pn + pn_off; const int row0 = u.pm * BM + wr * 64 + fr;
        if (gpn < 4) {
            bf16_t* O = (bf16_t*)(ws + (gpn < 2 ? WS_RQ : WS_RK)); const float sc = gpn < 2 ? 1.0f : 0.125f;
            const int head = 4 * (gpn & 1) + wc, d0 = 8 * fq; const f32x4* tab = (const f32x4*)(ws + WS_TAB);
#pragma unroll
            for (int ai = 0; ai < 2; ++ai)
#pragma unroll
                for (int m = 0; m < 4; ++m) { const int row = row0 + ai * HALF + m * 16; const float r = rowscale(ss, row) * sc;
                    const int t = (row & 4095) + 128;
                    const f32x4* tp = tab + ((size_t)t * 32 + d0) / 2;
                    u32x4 w1, w2; unsigned* p1 = (unsigned*)&w1; unsigned* p2 = (unsigned*)&w2;
#pragma unroll
                    for (int n = 0; n < 2; ++n) { const f32x4 cs0 = tp[2 * n], cs1 = tp[2 * n + 1]; float o1[4], o2[4];
                        const float c[4] = {cs0[0], cs0[2], cs1[0], cs1[2]}, s[4] = {cs0[1], cs0[3], cs1[1], cs1[3]};
#pragma unroll
                        for (int e = 0; e < 4; ++e) { const float t1 = acc[ai][0][m][n][e] * r, t2 = acc[ai][1][m][n][e] * r; o1[e] = t1 * c[e] - t2 * s[e]; o2[e] = t1 * s[e] + t2 * c[e]; }
                        p1[2 * n] = cvt_pk_bf16(o1[0], o1[1]); p1[2 * n + 1] = cvt_pk_bf16(o1[2], o1[3]); p2[2 * n] = cvt_pk_bf16(o2[0], o2[1]); p2[2 * n + 1] = cvt_pk_bf16(o2[2], o2[3]); }
                    bf16_t* op = O + (size_t)row * 512 + 64 * head + d0; *(u32x4*)op = w1; *(u32x4*)(op + 32) = w2; }
            return;
        }
        size_t off; int pitch, t0, act; float sc = 1.0f;
        if (gpn < 8) { off = WS_RV; pitch = 1024; t0 = 4; act = 0; }
        else if (gpn < 12) { off = WS_RG; pitch = 1024; t0 = 8; act = 1; }
        else if (gpn < 14) { off = WS_SQ; pitch = 512; t0 = 12; act = 0; sc = SBC2; }
        else if (gpn < 16) { off = WS_SK; pitch = 512; t0 = 14; act = 0; }
        else if (gpn < 18) { off = WS_SV; pitch = 512; t0 = 16; act = 0; }
        else if (gpn < 22) { off = WS_GA; pitch = 1024; t0 = 18; act = 2; }
        else { off = WS_GB; pitch = 1024; t0 = 22; act = 2; }
        bf16_t* O = (bf16_t*)(ws + off); const int col0 = (gpn - t0) * 256 + wc * 32 + 8 * fq;
#pragma unroll
        for (int ai = 0; ai < 2; ++ai)
#pragma unroll
            for (int m = 0; m < 4; ++m) { const int row = row0 + ai * HALF + m * 16; const float r = rowscale(ss, row) * sc; bf16_t* op = O + (size_t)row * pitch + col0;
#pragma unroll
                for (int bj = 0; bj < 2; ++bj) { u32x4 w; unsigned* wp = (unsigned*)&w;
#pragma unroll
                    for (int n = 0; n < 2; ++n) { float o[4];
#pragma unroll
                        for (int e = 0; e < 4; ++e) { float v = acc[ai][bj][m][n][e] * r; if (act == 1) v = v * fsigmoid(v); else if (act == 2) v = fsigmoid(v); o[e] = v; }
                        wp[2 * n] = cvt_pk_bf16(o[0], o[1]); wp[2 * n + 1] = cvt_pk_bf16(o[2], o[3]); }
                    *(u32x4*)(op + bj * HALF) = w; } }
    }
};
template <bool FIRST> struct EpiProj {
    static constexpr bool PERM = true, AFTER_DRAIN = false;
    const bf16_t* G; bf16_t* Y;
    __device__ __forceinline__ void operator()(const f32x4 (&acc)[2][2][4][2], const Unit& u, int wr, int wc, int fr, int fq) const {
        const int row0 = u.pm * BM + wr * 64 + fr; const int col0 = u.pn * BM + wc * 32 + 8 * fq;
#pragma unroll
        for (int ai = 0; ai < 2; ++ai)
#pragma unroll
            for (int m = 0; m < 4; ++m) { const size_t o = (size_t)(row0 + ai * HALF + m * 16) * 1024 + col0;
#pragma unroll
                for (int bj = 0; bj < 2; ++bj) { const u32x4 g = *(const u32x4*)(G + o + bj * HALF); u32x4 y = {0u, 0u, 0u, 0u}; if (!FIRST) y = *(const u32x4*)(Y + o + bj * HALF);
                    const unsigned* gp = (const unsigned*)&g; unsigned* yp = (unsigned*)&y;
#pragma unroll
                    for (int n = 0; n < 2; ++n) { const f32x4 a = acc[ai][bj][m][n];
                        float v0 = bflo(gp[2 * n]) * a[0], v1 = bfhi(gp[2 * n]) * a[1], v2 = bflo(gp[2 * n + 1]) * a[2], v3 = bfhi(gp[2 * n + 1]) * a[3];
                        if (!FIRST) { v0 += bflo(yp[2 * n]); v1 += bfhi(yp[2 * n]); v2 += bflo(yp[2 * n + 1]); v3 += bfhi(yp[2 * n + 1]); }
                        yp[2 * n] = cvt_pk_bf16(v0, v1); yp[2 * n + 1] = cvt_pk_bf16(v2, v3); }
                    *(u32x4*)(Y + o + bj * HALF) = y; } }
    }
};
template <class Epi, class Sched, bool ALIGN_EPI = false, bool SP2 = false>
__device__ __forceinline__ void gemm_phase(PG8_LAS unsigned char* lds, const Gemm g, const Sched& S, const Epi& E) {
    int tid_ = threadIdx.x; asm volatile("" : "+v"(tid_));
    const int tid = tid_, wid = __builtin_amdgcn_readfirstlane(tid >> 6), lane = tid & 63, wr = wid >> 2, wc = wid & 3, fr = lane & 15, fq = lane >> 4;
    const int K = g.K, nt = K / BK;
    unsigned voffA[2], voffB[2];
#pragma unroll
    for (int i = 0; i < 2; ++i) { int R, C; stage_rc(tid * 16 + i * 8192, R, C); const int Rb = Epi::PERM ? ((R & ~31) + perm32(R & 31)) : R;
        voffA[i] = (unsigned)(R * K + C) * 2u; voffB[i] = (unsigned)(Rb * K + C) * 2u; }
    const size_t kstep = (size_t)(BK * 2);
    const size_t hstep = (size_t)HALF * K * 2;
    const size_t tstep = 2 * hstep;
    const unsigned ldsw = (unsigned)wid * 1024u;
    const int aoff = lds_byte(wr * 64 + fr, fq * 8), boff = lds_byte(wc * 32 + fr, fq * 8);
#define PG8_SA(b, h) (((b) * 2 + (h)) * HTB)
#define PG8_SB(b, h) ((4 + (b) * 2 + (h)) * HTB)
#define PG8_STAGE(bufoff, gbase, voff) do { _Pragma("unroll") for (int _i = 0; _i < 2; ++_i) \
        __builtin_amdgcn_global_load_lds((const unsigned*)((const char*)(gbase) + (voff)[_i]), (PG8_LAS unsigned*)(lds + (bufoff) + ldsw + _i * 8192), 16, 0, 0); } while (0)
#define PG8_LDA(dst, b, h) do { _Pragma("unroll") for (int m = 0; m < 4; ++m) _Pragma("unroll") for (int k = 0; k < 2; ++k) dst[m][k] = *(const PG8_LAS bf16x8*)(lds + PG8_SA(b, h) + aoff + m * 2048 + k * 1024); } while (0)
#define PG8_LDB(dst, b, h) do { _Pragma("unroll") for (int n = 0; n < 2; ++n) _Pragma("unroll") for (int k = 0; k < 2; ++k) dst[n][k] = *(const PG8_LAS bf16x8*)(lds + PG8_SB(b, h) + boff + n * 2048 + k * 1024); } while (0)
#define PG8_MMA(ai, bj, At, Bt) do { __builtin_amdgcn_s_setprio(1); _Pragma("unroll") for (int m = 0; m < 4; ++m) _Pragma("unroll") for (int n = 0; n < 2; ++n) _Pragma("unroll") for (int k = 0; k < 2; ++k) \
        acc[ai][bj][m][n] = __builtin_amdgcn_mfma_f32_16x16x32_bf16(Bt[n][k], At[m][k], acc[ai][bj][m][n], 0, 0, 0); __builtin_amdgcn_s_setprio(0); } while (0)
#define PG8_WAIT_V(n) asm volatile("s_waitcnt vmcnt(" #n ")" ::: "memory")
#define PG8_WAIT_L(n) asm volatile("s_waitcnt lgkmcnt(" #n ")" ::: "memory")
#define PG8_BAR __builtin_amdgcn_s_barrier()
#define PG8_SCHED __builtin_amdgcn_sched_barrier(0)
    Unit cur, nxt; int ui = 0;
    if (!S.next(0, cur)) return;
    f32x4 acc[2][2][4][2];
#pragma unroll
    for (int a = 0; a < 2; ++a)
#pragma unroll
        for (int b = 0; b < 2; ++b)
#pragma unroll
            for (int m = 0; m < 4; ++m)
#pragma unroll
                for (int n = 0; n < 2; ++n) acc[a][b][m][n] = (f32x4){0.f, 0.f, 0.f, 0.f};
    bf16x8 At[4][2], B0[2][2], B1[2][2];
    const char* cA = (const char*)g.A + (size_t)cur.pm * tstep; const char* cB = (const char*)g.Bt + (size_t)cur.pn * tstep;
    S.a_ready(cur);
    if constexpr (SP2) {
        PG8_STAGE(PG8_SB(0, 0), cB, voffB); PG8_STAGE(PG8_SB(0, 1), cB + hstep, voffB); PG8_STAGE(PG8_SA(0, 0), cA, voffA); PG8_STAGE(PG8_SA(0, 1), cA + hstep, voffA);
        if (wr == 1) PG8_BAR;
        PG8_WAIT_V(2); PG8_BAR;
        PG8_STAGE(PG8_SB(1, 0), cB + kstep, voffB); PG8_STAGE(PG8_SA(1, 0), cA + kstep, voffA); PG8_STAGE(PG8_SB(1, 1), cB + hstep + kstep, voffB);
        PG8_WAIT_V(6); PG8_BAR;
    } else {
        PG8_STAGE(PG8_SB(0, 0), cB, voffB); PG8_STAGE(PG8_SA(0, 0), cA, voffA); PG8_STAGE(PG8_SB(0, 1), cB + hstep, voffB); PG8_STAGE(PG8_SA(0, 1), cA + hstep, voffA);
        if (wr == 1) PG8_BAR;
        PG8_WAIT_V(4); PG8_BAR;
        PG8_STAGE(PG8_SB(1, 0), cB + kstep, voffB); PG8_STAGE(PG8_SA(1, 0), cA + kstep, voffA); PG8_STAGE(PG8_SB(1, 1), cB + hstep + kstep, voffB);
        PG8_WAIT_V(6); PG8_BAR;
    }
    for (;;) {
        const bool has_next = S.next(ui + 1, nxt);
        const char* nA = has_next ? (const char*)g.A + (size_t)nxt.pm * tstep : cA; const char* nB = has_next ? (const char*)g.Bt + (size_t)nxt.pn * tstep : cB;
        for (int t = 0; t < nt; t += 2) {
            const bool last = (t == nt - 2);
            const char* a1 = cA + (size_t)(t + 1) * kstep;
            const char* a2 = last ? nA : cA + (size_t)(t + 2) * kstep; const char* b2 = last ? nB : cB + (size_t)(t + 2) * kstep;
            const char* a3 = a2 + kstep; const char* b3 = b2 + kstep;
            if (last && has_next) S.a_ready(nxt);
            if constexpr (SP2) {
            PG8_LDB(B0, 0, 0); PG8_LDB(B1, 0, 1); PG8_SCHED; PG8_LDA(At, 0, 0); PG8_STAGE(PG8_SA(1, 1), a1 + hstep, voffA);
            PG8_WAIT_V(8); PG8_WAIT_L(0); PG8_BAR; PG8_MMA(0, 0, At, B0); PG8_MMA(0, 1, At, B1); PG8_BAR; PG8_SCHED;
            PG8_LDA(At, 0, 1); PG8_STAGE(PG8_SB(0, 0), b2, voffB); PG8_STAGE(PG8_SB(0, 1), b2 + hstep, voffB); PG8_STAGE(PG8_SA(0, 0), a2, voffA);
            PG8_WAIT_V(8); PG8_WAIT_L(0); PG8_BAR; PG8_MMA(1, 0, At, B0); PG8_MMA(1, 1, At, B1); PG8_BAR; PG8_SCHED;
            PG8_LDB(B0, 1, 0); PG8_LDB(B1, 1, 1); PG8_SCHED; PG8_LDA(At, 1, 0); PG8_STAGE(PG8_SA(0, 1), a2 + hstep, voffA);
            PG8_WAIT_V(8); PG8_WAIT_L(0); PG8_BAR; PG8_MMA(0, 0, At, B0); PG8_MMA(0, 1, At, B1); PG8_BAR; PG8_SCHED;
            PG8_LDA(At, 1, 1); PG8_STAGE(PG8_SB(1, 0), b3, voffB); PG8_STAGE(PG8_SB(1, 1), b3 + hstep, voffB); PG8_STAGE(PG8_SA(1, 0), a3, voffA);
            PG8_WAIT_V(8); PG8_WAIT_L(0); PG8_BAR; PG8_MMA(1, 0, At, B0); PG8_MMA(1, 1, At, B1); PG8_BAR; PG8_SCHED;
            } else {
            PG8_LDB(B0, 0, 0); PG8_SCHED; PG8_LDA(At, 0, 0); PG8_STAGE(PG8_SA(1, 1), a1 + hstep, voffA);
            PG8_WAIT_L(8); PG8_BAR; PG8_WAIT_L(0); PG8_MMA(0, 0, At, B0); PG8_BAR; PG8_SCHED;
            PG8_LDB(B1, 0, 1); PG8_STAGE(PG8_SB(0, 0), b2, voffB);
            PG8_BAR; PG8_WAIT_L(0); PG8_MMA(0, 1, At, B1); PG8_BAR;
            PG8_LDA(At, 0, 1); PG8_STAGE(PG8_SA(0, 0), a2, voffA);
            PG8_BAR; PG8_WAIT_L(0); PG8_MMA(1, 0, At, B0); PG8_BAR; PG8_SCHED;
            PG8_STAGE(PG8_SB(0, 1), b2 + hstep, voffB);
            PG8_WAIT_V(6); PG8_BAR; PG8_MMA(1, 1, At, B1); PG8_BAR;
            PG8_LDB(B0, 1, 0); PG8_SCHED; PG8_LDA(At, 1, 0); PG8_STAGE(PG8_SA(0, 1), a2 + hstep, voffA);
            PG8_WAIT_L(8); PG8_BAR; PG8_WAIT_L(0); PG8_MMA(0, 0, At, B0); PG8_BAR; PG8_SCHED;
            PG8_LDB(B1, 1, 1); PG8_STAGE(PG8_SB(1, 0), b3, voffB);
            PG8_BAR; PG8_WAIT_L(0); PG8_MMA(0, 1, At, B1); PG8_BAR;
            PG8_LDA(At, 1, 1); PG8_STAGE(PG8_SA(1, 0), a3, voffA);
            PG8_BAR; PG8_WAIT_L(0); PG8_MMA(1, 0, At, B0); PG8_BAR; PG8_SCHED;
            PG8_STAGE(PG8_SB(1, 1), b3 + hstep, voffB);
            PG8_WAIT_V(6); PG8_BAR; PG8_MMA(1, 1, At, B1); PG8_BAR;
            }
        }
        if constexpr (ALIGN_EPI) { if (wr == 0) PG8_BAR; }
        if constexpr (!Epi::AFTER_DRAIN) { E(acc, cur, wr, wc, fr, fq); S.done(cur); }
        if (!has_next) break;
#pragma unroll
        for (int a = 0; a < 2; ++a)
#pragma unroll
            for (int b = 0; b < 2; ++b)
#pragma unroll
                for (int m = 0; m < 4; ++m)
#pragma unroll
                    for (int n = 0; n < 2; ++n) acc[a][b][m][n] = (f32x4){0.f, 0.f, 0.f, 0.f};
        cur = nxt; cA = nA; cB = nB; ++ui;
        if constexpr (ALIGN_EPI) { if (wr == 1) PG8_BAR; }
    }
    PG8_WAIT_V(0);
    if constexpr (!ALIGN_EPI) { if (wr == 0) PG8_BAR; }
    PG8_BAR;
    if constexpr (Epi::AFTER_DRAIN) { E.fused(acc, cur, wr, wc, fr, fq, lds, wid, lane); S.done(cur); }
#undef PG8_SA
#undef PG8_SB
#undef PG8_STAGE
#undef PG8_LDA
#undef PG8_LDB
#undef PG8_MMA
#undef PG8_WAIT_V
#undef PG8_WAIT_L
#undef PG8_BAR
#undef PG8_SCHED
}
}
#define GAS __attribute__((address_space(1)))
#define LAS __attribute__((address_space(3)))
typedef unsigned short bf16;
typedef unsigned v4u __attribute__((ext_vector_type(4)));
typedef float f32x4 __attribute__((ext_vector_type(4)));
#define LDS_WAIT() asm volatile("s_waitcnt lgkmcnt(0)" ::: "memory")
__device__ __forceinline__ unsigned f2bf(float f) { unsigned u = __builtin_bit_cast(unsigned, f); return (u + 0x7fffu + ((u >> 16) & 1u)) >> 16; }
__device__ __forceinline__ unsigned pk2(float lo, float hi) { return f2bf(lo) | (f2bf(hi) << 16); }
__device__ __forceinline__ float bf2f(unsigned short b) { return __builtin_bit_cast(float, (unsigned)b << 16); }
__device__ __forceinline__ float wave_sum(float v) {
#pragma unroll
    for (int o = 1; o < 64; o <<= 1) v += __shfl_xor(v, o);
    return v;
}
__device__ __forceinline__ int grow(int b, int t) { return t < 128 ? MR + (t - 112) : b * 4096 + (t - 128); }

#define XB_TMO      128
#define XB_XCNT(j)  (256  + 64 * (j))
#define XB_XSUB(j)  (1280 + 64 * (j))
#define XB_XGEN(j)  (2304 + 64 * (j))
#define XB_TOP      3328
#define XB_TOPGEN   3392
#define XCD_BAR_WORDS 3456
#define XB_SPIN_CAP (1u << 27)
__device__ __forceinline__ unsigned xb_ld(unsigned* p)              { return __hip_atomic_load(p, __ATOMIC_RELAXED, __HIP_MEMORY_SCOPE_AGENT); }
__device__ __forceinline__ unsigned xb_add(unsigned* p, unsigned v) { return __hip_atomic_fetch_add(p, v, __ATOMIC_RELAXED, __HIP_MEMORY_SCOPE_AGENT); }
__device__ __forceinline__ unsigned xb_xcc_id() { return (unsigned)__builtin_amdgcn_s_getreg((3 << 11) | 20) & 0xFu; }
#define XB_SPIN(cond, bar) do { unsigned _sp = 0; while (cond) { __builtin_amdgcn_s_sleep(1); \
    if ((++_sp & 255u) == 0u) { if (xb_ld(&(bar)[XB_TMO])) break; if (_sp > XB_SPIN_CAP) { atomicAdd(&(bar)[XB_TMO], 1u); break; } } } } while (0)
struct XcdBarrier { unsigned* bar; unsigned x; volatile LAS unsigned* st; };
__device__ __forceinline__ XcdBarrier xcd_barrier_post(unsigned* bar, volatile LAS unsigned* st) {
    XcdBarrier b; b.bar = bar; b.x = xb_xcc_id(); b.st = st;
    if (threadIdx.x == 0) (void)xb_add(&bar[XB_XCNT(b.x)], 1u);
    return b;
}
__device__ __forceinline__ void xcd_barrier_complete(unsigned* bar, unsigned x, unsigned& nloc, unsigned& nx) {
    const unsigned G = gridDim.x * gridDim.y * gridDim.z;
    unsigned sum, cnt, mine, sp = 0u;
    for (;;) {
        sum = 0u; cnt = 0u; mine = 0u;
#pragma unroll
        for (unsigned j = 0; j < 16; ++j) { const unsigned c = xb_ld(&bar[XB_XCNT(j)]); sum += c; cnt += (c > 0u) ? 1u : 0u; mine = (j == x) ? c : mine; }
        if (sum == G) break;
        __builtin_amdgcn_s_sleep(1);
        if ((++sp & 255u) == 0u) { if (xb_ld(&bar[XB_TMO])) break; if (sp > XB_SPIN_CAP) { atomicAdd(&bar[XB_TMO], 1u); break; } }
    }
    nloc = mine > 0u ? mine : 1u; nx = cnt > 0u ? cnt : 1u;
}
__device__ __forceinline__ void xcd_barrier(const XcdBarrier& b) {
    asm volatile("s_waitcnt vmcnt(0)" ::: "memory");
    __syncthreads();
    int t0_ = threadIdx.x; asm volatile("" : "+v"(t0_));
    if (t0_ == 0) {
        unsigned* bar = b.bar;
        __builtin_amdgcn_s_waitcnt(0);
        unsigned nloc = b.st[0], nx = b.st[1];
        if (nloc == 0u) { xcd_barrier_complete(bar, b.x, nloc, nx); b.st[0] = nloc; b.st[1] = nx; }
        const unsigned old = xb_add(&bar[XB_XSUB(b.x)], 1u);
        const unsigned gen = old / nloc;
        if (old + 1u == (gen + 1u) * nloc) {
            __builtin_amdgcn_fence(__ATOMIC_RELEASE, "agent");
            asm volatile("s_waitcnt vmcnt(0)" ::: "memory");
            const unsigned og = xb_add(&bar[XB_TOP], 1u);
            const unsigned tg = og / nx;
            if (og + 1u == (tg + 1u) * nx) xb_add(&bar[XB_TOPGEN], 1u);
            else XB_SPIN(xb_ld(&bar[XB_TOPGEN]) == tg, bar);
            __builtin_amdgcn_fence(__ATOMIC_ACQUIRE, "agent");
            xb_add(&bar[XB_XGEN(b.x)], 1u);
            asm volatile("s_waitcnt vmcnt(0)" ::: "memory");
        } else {
            XB_SPIN(xb_ld(&bar[XB_XGEN(b.x)]) == gen, bar);
            __builtin_amdgcn_fence(__ATOMIC_ACQUIRE, "agent");
            asm volatile("s_waitcnt vmcnt(0)" ::: "memory");
        }
    }
    __syncthreads();
}

constexpr int NWAVES = 8;
constexpr int RING_BYTES = 131072, MISC_OFF = RING_BYTES + 320, LDS_BYTES = 147456;

__device__ __forceinline__ void transpose_item(const float* W, int K, int N, bf16* WT, int drow0, int scol0, int k0, const float* gain, LAS float* scr, int lane) {
    { const int c4 = (lane & 7) * 4, kr = lane >> 3; const float* wp = W + (size_t)(k0 + kr) * N + scol0 + c4; const size_t rstep = (size_t)8 * N;
      f32x4 v[8];
#pragma unroll
      for (int i = 0; i < 8; ++i) v[i] = *(const f32x4*)(wp + i * rstep);
#pragma unroll
      for (int i = 0; i < 8; ++i) { const int kk = 8 * i + kr; const float g = gain ? gain[k0 + kk] : 1.0f; LAS float* sp = scr + kk * 33 + c4; sp[0] = v[i][0] * g; sp[1] = v[i][1] * g; sp[2] = v[i][2] * g; sp[3] = v[i][3] * g; } }
    LDS_WAIT(); asm volatile("" ::: "memory");
    const int c = lane & 7;
#pragma unroll
    for (int j = 0; j < 4; ++j) { const int n = (lane >> 3) + 8 * j; const LAS float* s = scr + (8 * c) * 33 + n;
        v4u o; o.x = pk2(s[0 * 33], s[1 * 33]); o.y = pk2(s[2 * 33], s[3 * 33]); o.z = pk2(s[4 * 33], s[5 * 33]); o.w = pk2(s[6 * 33], s[7 * 33]);
        *(v4u*)(WT + (size_t)(drow0 + n) * K + k0 + 8 * c) = o; }
    LDS_WAIT(); asm volatile("" ::: "memory");
}
struct In { const float *x, *meta, *ffn1_norm, *ffn1_gu, *ffn1_dn, *mix_norm, *w_in, *ret_gn, *w_ret, *w_sb, *w_out, *ffn2_norm, *ffn2_gu, *ffn2_dn, *final_norm; };
__device__ __forceinline__ int gu_src(int g) { const int pn = g >> 3, q = g & 7; return q < 4 ? 128 * pn + 32 * q : 2816 + 128 * pn + 32 * (q - 4); }
__device__ __forceinline__ int in_src(int g) { const int pn = g >> 3, q = g & 7; if (pn >= 4) return 32 * g; const int base = pn < 2 ? 0 : 512, head = 4 * (pn & 1) + (q & 3); return base + 64 * head + 32 * (q >> 2); }
constexpr int CV_GU1 = 0, CV_GU2 = 2816, CV_DN1 = 5632, CV_DN2 = 7040, CV_IN = 8448, CV_RSO = 11776, CV_END = 13056;
__device__ __forceinline__ void convert_range(const In& in, int l, int it_lo, int it_hi, unsigned char* ws, LAS unsigned char* lds, int gw, int NGW, int wave, int lane_in) {
    int lane = lane_in; asm volatile("" : "+v"(lane));
    LAS float* scr = (LAS float*)(lds + wave * 16384);
    constexpr int I_GU = 16 * 176, I_DN = 44 * 32, I_IN = 16 * 208, I_RET = 16 * 32, I_SB = 8 * 32, I_OUT = 16 * 32;
#pragma unroll 1
    for (int it = it_lo + gw; it < it_hi; it += NGW) {
        int r = it; const float* W; const float* gain = nullptr; int K = DM, N = DM, ng = 32, kind = 0; size_t woff, doff;
        if (r < I_GU) { W = in.ffn1_gu; woff = (size_t)l * DM * 5632; N = 5632; ng = 176; kind = 1; gain = in.ffn1_norm + l * DM; doff = W_GU1; }
        else if ((r -= I_GU) < I_GU) { W = in.ffn2_gu; woff = (size_t)l * DM * 5632; N = 5632; ng = 176; kind = 1; gain = in.ffn2_norm + l * DM; doff = W_GU2; }
        else if ((r -= I_GU) < I_DN) { W = in.ffn1_dn; woff = (size_t)l * DFF * DM; K = DFF; doff = W_DN1; }
        else if ((r -= I_DN) < I_DN) { W = in.ffn2_dn; woff = (size_t)l * DFF * DM; K = DFF; doff = W_DN2; }
        else if ((r -= I_DN) < I_IN) { W = in.w_in; woff = (size_t)l * DM * DIN; N = DIN; ng = 208; kind = 2; gain = in.mix_norm + l * DM; doff = W_IN; }
        else if ((r -= I_IN) < I_RET) { W = in.w_ret; woff = (size_t)l * DM * DM; doff = W_RET; }
        else if ((r -= I_RET) < I_SB) { W = in.w_sb; woff = (size_t)l * 512 * DM; K = 512; doff = W_SB; }
        else { r -= I_SB; W = in.w_out; woff = (size_t)l * DM * DM; doff = W_OUT; }
        const int g = r % ng, kb = r / ng; const int sc = kind == 1 ? gu_src(g) : kind == 2 ? in_src(g) : 32 * g;
        transpose_item(W + woff, K, N, (bf16*)(ws + WS_W + doff), 32 * g, sc, 64 * kb, gain, scr, lane);
    }
}
__device__ __forceinline__ void init_rows(const In& in, float* out, unsigned char* ws, int gw, int NGW, int lane) {
    unsigned long long* ss = (unsigned long long*)(ws + WS_SS); float* hside = (float*)(ws + WS_HSIDE); bf16* HB = (bf16*)(ws + WS_HB);
    for (int m = gw; m < MR + 16; m += NGW) {
        f32x4 v[4]; float s = 0.f; float* hp; const f32x4* xr;
        if (m < MR) { xr = (const f32x4*)(in.x + (size_t)m * DM) + lane; hp = out + (size_t)m * DM; }
        else { xr = (const f32x4*)(in.meta + (size_t)(m - MR) * DM) + lane; hp = hside + (size_t)(m - MR) * DM; }
#pragma unroll
        for (int j = 0; j < 4; ++j) v[j] = xr[64 * j];
#pragma unroll
        for (int j = 0; j < 4; ++j) { s += (v[j].x * v[j].x + v[j].y * v[j].y) + (v[j].z * v[j].z + v[j].w * v[j].w); if (m >= MR) ((f32x4*)hp + lane)[64 * j] = v[j];
            ((unsigned long long*)(HB + (size_t)m * DM) + lane)[64 * j] = (unsigned long long)pk2(v[j].x, v[j].y) | ((unsigned long long)pk2(v[j].z, v[j].w) << 32); }
        s = wave_sum(s);
        if (lane == 0) ss[m] = (unsigned long long)(s * 1048576.0f + 0.5f);
    }
    const int gt = gw * 64 + lane, GT = NGW * 64;
    for (int i = gt; i < 6 * M; i += GT) ss[M + i] = 0ull;
    float* tab = (float*)(ws + WS_TAB);
    for (int i = gt; i < LSEQ * 32; i += GT) { const int t = i >> 5, d = i & 31;
        const float freq = __builtin_amdgcn_exp2f(-(float)d * (13.287712379549449f / 32.0f));
        const double rev = (double)(t - 112) * (double)freq * 0.15915494309189535; const float fr_ = (float)(rev - __builtin_rint(rev));
        tab[2 * i] = __builtin_amdgcn_cosf(fr_); tab[2 * i + 1] = __builtin_amdgcn_sinf(fr_); }
}
__device__ __forceinline__ void final_norm(const In& in, float* out, unsigned char* ws, int gw, int NGW, int lane) {
    const unsigned long long* ss = (const unsigned long long*)(ws + WS_SS) + 6 * M;
    for (int m = gw; m < MR; m += NGW) { const float r = __builtin_amdgcn_rsqf((float)ss[m] * (1.0f / (1024.0f * 1048576.0f)) + EPS); f32x4* hp = (f32x4*)(out + (size_t)m * DM) + lane; const f32x4* gp = (const f32x4*)in.final_norm + lane;
#pragma unroll
        for (int j = 0; j < 4; ++j) { f32x4 v = hp[64 * j]; const f32x4 g = gp[64 * j]; v = v * r * g; hp[64 * j] = v; } }
}

namespace sbk {
typedef short bf16x8 __attribute__((ext_vector_type(8)));
typedef float f32x16 __attribute__((ext_vector_type(16)));
typedef unsigned u32x2 __attribute__((ext_vector_type(2)));
typedef unsigned u32x4 __attribute__((ext_vector_type(4)));
constexpr int KSTR = 144, VSTR = 136, KBUF = 64 * KSTR, VBUF = 64 * VSTR, BUFB = KBUF + VBUF;
typedef float f32x2_t __attribute__((ext_vector_type(2))); typedef __bf16 bf16x2_t __attribute__((ext_vector_type(2)));
__device__ __forceinline__ unsigned cvtpk(float lo, float hi) { f32x2_t v = {lo, hi}; bf16x2_t b = __builtin_convertvector(v, bf16x2_t); return __builtin_bit_cast(unsigned, b); }

template <bool SPECIAL> __device__ __forceinline__ void sb_half(f32x16 (&o)[2], float& carry, const bf16x8 (&qf)[4], LAS const unsigned char* Kb, LAS const unsigned char* Vb,
                                                                int kh, int k0, int qpos, int r, int hi, float mh) {
    f32x16 p;
#pragma unroll
    for (int i = 0; i < 16; ++i) p[i] = 0.f;
    LAS const unsigned char* kp = Kb + (32 * kh + r) * KSTR + hi * 16;
#pragma unroll
    for (int s = 0; s < 4; ++s) { const bf16x8 kf = *(LAS const bf16x8*)(kp + 32 * s); p = __builtin_amdgcn_mfma_f32_32x32x16_bf16(kf, qf[s], p, 0, 0, 0); }
    float l[16], tz[16];
#pragma unroll
    for (int i = 0; i < 16; ++i) { const float z = fminf(p[i], 60.f); const float e = __builtin_amdgcn_exp2f(z); l[i] = __builtin_amdgcn_logf(1.0f + e); tz[i] = z - l[i]; }
    if (SPECIAL) {
#pragma unroll
        for (int i = 0; i < 16; ++i) { const int key = k0 + 8 * (i >> 2) + 4 * hi + (i & 3); const bool ok = (key < qpos) && (key >= 112); l[i] = ok ? l[i] : 0.f; tz[i] = ok ? tz[i] : -1e30f; }
    }
    float T[4], S[4], sfx[16];
#pragma unroll
    for (int g = 0; g < 4; ++g) { sfx[4 * g + 3] = 0.f; sfx[4 * g + 2] = l[4 * g + 3]; sfx[4 * g + 1] = sfx[4 * g + 2] + l[4 * g + 2]; sfx[4 * g] = sfx[4 * g + 1] + l[4 * g + 1]; T[g] = sfx[4 * g] + l[4 * g]; }
#pragma unroll
    for (int g = 0; g < 4; ++g) S[g] = T[g] + __shfl_xor(T[g], 32);
    float R[4]; R[3] = carry; R[2] = R[3] + S[3]; R[1] = R[2] + S[2]; R[0] = R[1] + S[1]; carry = R[0] + S[0];
    unsigned pw[8];
#pragma unroll
    for (int g = 0; g < 4; ++g) { const float off = R[g] + mh * (S[g] - T[g]); float a[4];
#pragma unroll
        for (int e = 0; e < 4; ++e) a[e] = __builtin_amdgcn_exp2f(tz[4 * g + e] - (off + sfx[4 * g + e]));
        pw[2 * g] = cvtpk(a[0], a[1]); pw[2 * g + 1] = cvtpk(a[2], a[3]); }
    const u32x4 pb0 = {pw[0], pw[1], pw[2], pw[3]}, pb1 = {pw[4], pw[5], pw[6], pw[7]};
#pragma unroll
    for (int dt = 0; dt < 2; ++dt) {
        LAS const unsigned char* vp = Vb + (32 * dt + r) * VSTR + (32 * kh + 4 * hi) * 2;
        const u32x2 a0 = *(LAS const u32x2*)(vp), a1 = *(LAS const u32x2*)(vp + 16), b0 = *(LAS const u32x2*)(vp + 32), b1 = *(LAS const u32x2*)(vp + 48);
        const u32x4 v0 = {a0.x, a0.y, a1.x, a1.y}, v1 = {b0.x, b0.y, b1.x, b1.y};
        o[dt] = __builtin_amdgcn_mfma_f32_32x32x16_bf16(__builtin_bit_cast(bf16x8, v0), __builtin_bit_cast(bf16x8, pb0), o[dt], 0, 0, 0);
        o[dt] = __builtin_amdgcn_mfma_f32_32x32x16_bf16(__builtin_bit_cast(bf16x8, v1), __builtin_bit_cast(bf16x8, pb1), o[dt], 0, 0, 0);
    }
}

__device__ __forceinline__ int krow(int b, int kt, int lkey) { return kt >= 2 ? b * 4096 + 64 * kt - 128 + lkey : MR + (lkey >= 48 ? lkey - 48 : 0); }
__device__ __forceinline__ void sb_unit(unsigned char* ws, LAS unsigned char* lds, int b, int h, int tq0, int nrows, int tid) {
    const int lane = tid & 63, wave = __builtin_amdgcn_readfirstlane(tid >> 6), r = lane & 31, hi = lane >> 5;
    const unsigned short* SQ = (const unsigned short*)(ws + WS_SQ); const unsigned short* SK = (const unsigned short*)(ws + WS_SK); const unsigned short* SV = (const unsigned short*)(ws + WS_SV);
    const bool metau = tq0 == 0; const bool wact = metau ? (wave == 3) : (32 * wave < nrows); const int qw = tq0 + 32 * wave; const int qpos = qw + r;
    const int qrow = metau ? MR + (qpos >= 112 && qpos < 128 ? qpos - 112 : 0) : b * 4096 + (tq0 - 128) + (wact ? 32 * wave : 0) + r;
    bf16x8 qf[4];
#pragma unroll
    for (int s = 0; s < 4; ++s) qf[s] = *(const bf16x8*)(SQ + (size_t)qrow * 512 + 64 * h + 16 * s + 8 * hi);
    f32x16 o[2];
#pragma unroll
    for (int i = 0; i < 16; ++i) { o[0][i] = 0.f; o[1][i] = 0.f; }
    float carry = 0.f; const float mh = hi == 0 ? 1.0f : 0.0f;
    const int kt_hi = (tq0 + nrows - 1) >> 6;
    const int lkey = tid >> 3, lch = tid & 7;
    constexpr int WIN = 7;
    LAS unsigned* flags = (LAS unsigned*)(lds + WIN * BUFB);
    bool wdone = !wact;
    int kt_top = kt_hi;
#pragma unroll 1
    for (;;) {
        const int nt = kt_top < WIN ? kt_top : WIN;
        u32x4 kreg[WIN], vreg[WIN];
#pragma unroll
        for (int sl = 0; sl < WIN; ++sl) if (sl < nt) { const size_t gr = (size_t)krow(b, kt_top - sl, lkey) * 512 + 64 * h + 8 * lch; kreg[sl] = *(const u32x4*)(SK + gr); vreg[sl] = *(const u32x4*)(SV + gr); }
        __syncthreads();
#pragma unroll
        for (int sl = 0; sl < WIN; ++sl) if (sl < nt) { LAS unsigned char* Kb = lds + sl * BUFB; LAS unsigned char* Vb = Kb + KBUF;
            *(LAS u32x4*)(Kb + lkey * KSTR + lch * 16) = kreg[sl];
            LAS unsigned short* vd = (LAS unsigned short*)(Vb + (8 * lch) * VSTR + lkey * 2); const unsigned* vw = (const unsigned*)&vreg[sl];
#pragma unroll
            for (int e = 0; e < 4; ++e) { vd[(2 * e) * (VSTR / 2)] = (unsigned short)(vw[e] & 0xffffu); vd[(2 * e + 1) * (VSTR / 2)] = (unsigned short)(vw[e] >> 16); } }
        __syncthreads();
        if (!wdone) {
#pragma unroll 1
            for (int sl = 0; sl < nt; ++sl) { const int kt = kt_top - sl; LAS unsigned char* Kb = lds + sl * BUFB; LAS unsigned char* Vb = Kb + KBUF;
                if (64 * kt > qw) continue;
#pragma unroll
                for (int kh = 1; kh >= 0; --kh) { const int k0 = 64 * kt + 32 * kh;
                    if (k0 <= qw && k0 >= 96) {
                        if (k0 == qw || k0 == 96) sb_half<true>(o, carry, qf, Kb, Vb, kh, k0, qpos, r, hi, mh);
                        else sb_half<false>(o, carry, qf, Kb, Vb, kh, k0, qpos, r, hi, mh);
                    } }
                if (__all(carry >= 150.f)) { wdone = true; break; }
            }
        }
        kt_top -= nt;
        if (kt_top < 1) break;
        if (lane == 0) flags[wave] = wdone ? 1u : 0u;
        __syncthreads();
        { const u32x4 f0 = *(LAS const u32x4*)(flags), f1 = *(LAS const u32x4*)(flags + 4);
          if ((f0.x & f0.y & f0.z & f0.w & f1.x & f1.y & f1.z & f1.w) != 0u) break; }
    }
    if (wact && (!metau || qpos >= 112)) { unsigned short* op = (unsigned short*)(ws + WS_SQ) + (size_t)qrow * 512 + 64 * h + 4 * hi;
#pragma unroll
        for (int dt = 0; dt < 2; ++dt)
#pragma unroll
            for (int g = 0; g < 4; ++g) { u32x2 w; w.x = cvtpk(o[dt][4 * g], o[dt][4 * g + 1]); w.y = cvtpk(o[dt][4 * g + 2], o[dt][4 * g + 3]); *(u32x2*)(op + 32 * dt + 8 * g) = w; } }
    __syncthreads();
}
}
namespace retk {
typedef short bf16x8 __attribute__((ext_vector_type(8)));
typedef float f32x16 __attribute__((ext_vector_type(16)));
typedef float f32x4 __attribute__((ext_vector_type(4)));
typedef float f32x2 __attribute__((ext_vector_type(2)));
typedef unsigned u32x2 __attribute__((ext_vector_type(2)));
typedef unsigned u32x4 __attribute__((ext_vector_type(4)));
constexpr int KSTR = 144, TSTR = 272;
constexpr int K_OFF = 0, KDT_OFF = 128 * KSTR, VT_OFF = KDT_OFF + 64 * TSTR, RT_OFF = VT_OFF + 128 * TSTR, GN_OFF = RT_OFF + 128 * KSTR, LDS_END = GN_OFF + 2048;
static_assert(LDS_END <= 131072, "retention LDS");
using sbk::cvtpk;
__device__ __forceinline__ int crow(int i, int hi) { return (i & 3) + 8 * (i >> 2) + 4 * hi; }
__device__ __forceinline__ float loggamma2(int h) { return __builtin_amdgcn_logf(1.0f - __builtin_amdgcn_exp2f(-5.0f - (float)h)); }
__device__ __forceinline__ void scatter_t(LAS unsigned char* base, int ch, int ls, const u32x4& v) {
    LAS unsigned short* d = (LAS unsigned short*)(base + (8 * ch) * TSTR + ls * 2); const unsigned* w = (const unsigned*)&v;
#pragma unroll
    for (int e = 0; e < 4; ++e) { d[(2 * e) * (TSTR / 2)] = (unsigned short)(w[e] & 0xffffu); d[(2 * e + 1) * (TSTR / 2)] = (unsigned short)(w[e] >> 16); }
}

__device__ __forceinline__ void kv_item(unsigned char* ws, LAS unsigned char* lds, int b, int h, int n, int tid) {
    const int lane = tid & 63, wave = __builtin_amdgcn_readfirstlane(tid >> 6), r = lane & 31, hi = lane >> 5, et = wave >> 1, dtl = wave & 1;
    const unsigned short* RK = (const unsigned short*)(ws + WS_RK); const unsigned short* RV = (const unsigned short*)(ws + WS_RV);
    const int ls = tid & 127, lc = tid >> 7; const int rowbase = n > 0 ? b * 4096 + 128 * (n - 1) : MR - 112;
    const float lg = loggamma2(h), kdec = __builtin_amdgcn_exp2f((float)(127 - ls) * lg);
    u32x4 kreg[2], vreg[4];
    const bool kvalid = n > 0 || ls >= 112;
#pragma unroll
    for (int i = 0; i < 2; ++i) kreg[i] = kvalid ? *(const u32x4*)(RK + (size_t)(rowbase + ls) * 512 + 64 * h + 8 * (lc + 4 * i)) : (u32x4){0u, 0u, 0u, 0u};
#pragma unroll
    for (int i = 0; i < 4; ++i) vreg[i] = kvalid ? *(const u32x4*)(RV + (size_t)(rowbase + ls) * 1024 + 128 * h + 8 * (lc + 4 * i)) : (u32x4){0u, 0u, 0u, 0u};
#pragma unroll
    for (int i = 0; i < 2; ++i) { const unsigned* kw = (const unsigned*)&kreg[i]; u32x4 kd;  unsigned* kdp = (unsigned*)&kd;
#pragma unroll
        for (int e = 0; e < 4; ++e) kdp[e] = cvtpk(__builtin_bit_cast(float, kw[e] << 16) * kdec, __builtin_bit_cast(float, kw[e] & 0xffff0000u) * kdec);
        scatter_t(lds + KDT_OFF, lc + 4 * i, ls, kd); }
#pragma unroll
    for (int i = 0; i < 4; ++i) scatter_t(lds + VT_OFF, lc + 4 * i, ls, vreg[i]);
    __syncthreads();
    f32x16 rs;
#pragma unroll
    for (int i = 0; i < 16; ++i) rs[i] = 0.f;
    { LAS const unsigned char* ap = lds + VT_OFF + (32 * et + r) * TSTR + hi * 16; LAS const unsigned char* bp = lds + KDT_OFF + (32 * dtl + r) * TSTR + hi * 16;
#pragma unroll
      for (int ks = 0; ks < 8; ++ks) rs = __builtin_amdgcn_mfma_f32_32x32x16_bf16(*(LAS const bf16x8*)(ap + 32 * ks), *(LAS const bf16x8*)(bp + 32 * ks), rs, 0, 0, 0); }
    u32x4 o0, o1; unsigned* p0 = (unsigned*)&o0; unsigned* p1 = (unsigned*)&o1;
#pragma unroll
    for (int e = 0; e < 4; ++e) { p0[e] = cvtpk(rs[2 * e], rs[2 * e + 1]); p1[e] = cvtpk(rs[8 + 2 * e], rs[8 + 2 * e + 1]); }
    u32x4* dst = (u32x4*)(ws + WS_KV + ((size_t)((b * 8 + h) * 33 + n) * 8 + wave) * 2048) + 2 * lane;
    dst[0] = o0; dst[1] = o1;
    __syncthreads();
}

__device__ __forceinline__ void out_item(unsigned char* ws, const float* ret_gn, LAS unsigned char* lds, int b, int h, int n, int tid) {
    const int lane = tid & 63, wave = __builtin_amdgcn_readfirstlane(tid >> 6), r = lane & 31, hi = lane >> 5;
    const int rb = wave & 3, dh = wave >> 2, et = wave >> 1, dtl = wave & 1;
    const unsigned short* RQ = (const unsigned short*)(ws + WS_RQ); const unsigned short* RK = (const unsigned short*)(ws + WS_RK); const unsigned short* RV = (const unsigned short*)(ws + WS_RV);
    unsigned short* RG = (unsigned short*)(ws + WS_RG);
    const float lg = loggamma2(h);
    const float cd = __builtin_amdgcn_exp2f(128.0f * lg), qdec = __builtin_amdgcn_exp2f((float)(32 * rb + r + 1) * lg);
    const int ls = tid & 127, lc = tid >> 7; const int rowbase = n > 0 ? b * 4096 + 128 * (n - 1) : MR - 112;
    u32x4 kreg[2], vreg[4]; bf16x8 qf[4];
    const bool kvalid = n > 0 || ls >= 112;
#pragma unroll
    for (int i = 0; i < 2; ++i) kreg[i] = kvalid ? *(const u32x4*)(RK + (size_t)(rowbase + ls) * 512 + 64 * h + 8 * (lc + 4 * i)) : (u32x4){0u, 0u, 0u, 0u};
#pragma unroll
    for (int i = 0; i < 4; ++i) vreg[i] = kvalid ? *(const u32x4*)(RV + (size_t)(rowbase + ls) * 1024 + 128 * h + 8 * (lc + 4 * i)) : (u32x4){0u, 0u, 0u, 0u};
    const bool qvalid = n > 0 || (32 * rb + r) >= 112;
#pragma unroll
    for (int s = 0; s < 4; ++s) qf[s] = qvalid ? *(const bf16x8*)(RQ + (size_t)(rowbase + 32 * rb + r) * 512 + 64 * h + 16 * s + 8 * hi) : (bf16x8){0, 0, 0, 0, 0, 0, 0, 0};
    unsigned short* gp = RG + (size_t)(rowbase + 32 * rb + r) * 1024 + 128 * h + 64 * dh + 4 * hi; const float* gnp = ret_gn + 128 * h + 64 * dh + 4 * hi;
    u32x2 rgv[8];
#pragma unroll
    for (int j = 0; j < 8; ++j) rgv[j] = qvalid ? *(const u32x2*)(gp + 32 * (j >> 2) + 8 * (j & 3)) : (u32x2){0u, 0u};
    f32x16 rs;
#pragma unroll
    for (int i = 0; i < 16; ++i) rs[i] = 0.f;
    { const u32x4* src = (const u32x4*)(ws + WS_KV + ((size_t)((b * 8 + h) * 33) * 8 + wave) * 2048) + 2 * lane;
#pragma unroll 8
      for (int m = 0; m < n; ++m) { const u32x4 a0 = src[(size_t)m * 1024], a1 = src[(size_t)m * 1024 + 1]; const unsigned* q0 = (const unsigned*)&a0; const unsigned* q1 = (const unsigned*)&a1;
#pragma unroll
          for (int e = 0; e < 4; ++e) { rs[2 * e] = rs[2 * e] * cd + __builtin_bit_cast(float, q0[e] << 16); rs[2 * e + 1] = rs[2 * e + 1] * cd + __builtin_bit_cast(float, q0[e] & 0xffff0000u);
              rs[8 + 2 * e] = rs[8 + 2 * e] * cd + __builtin_bit_cast(float, q1[e] << 16); rs[8 + 2 * e + 1] = rs[8 + 2 * e + 1] * cd + __builtin_bit_cast(float, q1[e] & 0xffff0000u); } } }
#pragma unroll
    for (int i = 0; i < 2; ++i) *(LAS u32x4*)(lds + K_OFF + ls * KSTR + (lc + 4 * i) * 16) = kreg[i];
#pragma unroll
    for (int i = 0; i < 4; ++i) scatter_t(lds + VT_OFF, lc + 4 * i, ls, vreg[i]);
#pragma unroll
    for (int i = 0; i < 16; i += 2) { const unsigned w = cvtpk(rs[i], rs[i + 1]);
        *(LAS unsigned short*)(lds + RT_OFF + (32 * et + crow(i, hi)) * KSTR + (32 * dtl + r) * 2) = (unsigned short)(w & 0xffffu);
        *(LAS unsigned short*)(lds + RT_OFF + (32 * et + crow(i + 1, hi)) * KSTR + (32 * dtl + r) * 2) = (unsigned short)(w >> 16); }
    __syncthreads();
    f32x16 o[2];
#pragma unroll
    for (int i = 0; i < 16; ++i) { o[0][i] = 0.f; o[1][i] = 0.f; }
#pragma unroll 1
    for (int sb = 0; sb <= rb; ++sb) {
        f32x16 p;
#pragma unroll
        for (int i = 0; i < 16; ++i) p[i] = 0.f;
        LAS const unsigned char* kp = lds + K_OFF + (32 * sb + r) * KSTR + hi * 16;
#pragma unroll
        for (int s = 0; s < 4; ++s) p = __builtin_amdgcn_mfma_f32_32x32x16_bf16(*(LAS const bf16x8*)(kp + 32 * s), qf[s], p, 0, 0, 0);
        unsigned pw[8]; const int dl0 = 32 * (rb - sb) + r;
#pragma unroll
        for (int i = 0; i < 16; i += 2) { const int d0 = dl0 - crow(i, hi), d1 = d0 - 1;
            const float a0 = d0 >= 0 ? p[i] * __builtin_amdgcn_exp2f((float)d0 * lg) : 0.f, a1 = d1 >= 0 ? p[i + 1] * __builtin_amdgcn_exp2f((float)d1 * lg) : 0.f;
            pw[i >> 1] = cvtpk(a0, a1); }
        const u32x4 pb0 = {pw[0], pw[1], pw[2], pw[3]}, pb1 = {pw[4], pw[5], pw[6], pw[7]};
#pragma unroll
        for (int e2 = 0; e2 < 2; ++e2) {
            LAS const unsigned char* vp = lds + VT_OFF + (32 * (2 * dh + e2) + r) * TSTR + (32 * sb + 4 * hi) * 2;
            const u32x2 a0 = *(LAS const u32x2*)(vp), a1 = *(LAS const u32x2*)(vp + 16), b0 = *(LAS const u32x2*)(vp + 32), b1 = *(LAS const u32x2*)(vp + 48);
            const u32x4 v0 = {a0.x, a0.y, a1.x, a1.y}, v1 = {b0.x, b0.y, b1.x, b1.y};
            o[e2] = __builtin_amdgcn_mfma_f32_32x32x16_bf16(__builtin_bit_cast(bf16x8, v0), __builtin_bit_cast(bf16x8, pb0), o[e2], 0, 0, 0);
            o[e2] = __builtin_amdgcn_mfma_f32_32x32x16_bf16(__builtin_bit_cast(bf16x8, v1), __builtin_bit_cast(bf16x8, pb1), o[e2], 0, 0, 0);
        }
    }
    if (n > 0) {
#pragma unroll
        for (int e2 = 0; e2 < 2; ++e2) { f32x16 x;
#pragma unroll
            for (int i = 0; i < 16; ++i) x[i] = 0.f;
            LAS const unsigned char* rp = lds + RT_OFF + (32 * (2 * dh + e2) + r) * KSTR + hi * 16;
#pragma unroll
            for (int s = 0; s < 4; ++s) x = __builtin_amdgcn_mfma_f32_32x32x16_bf16(*(LAS const bf16x8*)(rp + 32 * s), qf[s], x, 0, 0, 0);
#pragma unroll
            for (int i = 0; i < 16; ++i) o[e2][i] += x[i] * qdec; }
    }
    float s1 = 0.f, s2 = 0.f;
#pragma unroll
    for (int i = 0; i < 16; ++i) { s1 += o[0][i] + o[1][i]; s2 += o[0][i] * o[0][i] + o[1][i] * o[1][i]; }
    s1 += __shfl_xor(s1, 32); s2 += __shfl_xor(s2, 32);
    LAS f32x2* gnx = (LAS f32x2*)(lds + GN_OFF);
    if (hi == 0) gnx[dh * 128 + 32 * rb + r] = (f32x2){s1, s2};
    __syncthreads();
    { const f32x2 ot = gnx[(dh ^ 1) * 128 + 32 * rb + r]; s1 += ot.x; s2 += ot.y; }
    const float mu = s1 * (1.0f / 128.0f); const float rstd = __builtin_amdgcn_rsqf(fmaxf(s2 * (1.0f / 128.0f) - mu * mu, 0.f) + EPS);
#pragma unroll
    for (int e2 = 0; e2 < 2; ++e2)
#pragma unroll
        for (int g = 0; g < 4; ++g) { const f32x4 gv = *(const f32x4*)(gnp + 32 * e2 + 8 * g); const u32x2 rg = rgv[4 * e2 + g];
            const float y0 = (o[e2][4 * g] - mu) * rstd * gv[0] * __builtin_bit_cast(float, rg.x << 16), y1 = (o[e2][4 * g + 1] - mu) * rstd * gv[1] * __builtin_bit_cast(float, rg.x & 0xffff0000u);
            const float y2 = (o[e2][4 * g + 2] - mu) * rstd * gv[2] * __builtin_bit_cast(float, rg.y << 16), y3 = (o[e2][4 * g + 3] - mu) * rstd * gv[3] * __builtin_bit_cast(float, rg.y & 0xffff0000u);
            u32x2 w; w.x = cvtpk(y0, y1); w.y = cvtpk(y2, y3); if (qvalid) *(u32x2*)(gp + 32 * e2 + 8 * g) = w; }
    __syncthreads();
}

__device__ __forceinline__ void out_group(unsigned char* ws, const float* ret_gn, LAS unsigned char* lds, int b, int h, int g, int tid) {
    const int lane = tid & 63, wave = __builtin_amdgcn_readfirstlane(tid >> 6), r = lane & 31, hi = lane >> 5;
    const int rb = wave & 3, dh = wave >> 2, et = wave >> 1, dtl = wave & 1;
    const unsigned short* RQ = (const unsigned short*)(ws + WS_RQ); const unsigned short* RK = (const unsigned short*)(ws + WS_RK); const unsigned short* RV = (const unsigned short*)(ws + WS_RV);
    unsigned short* RG = (unsigned short*)(ws + WS_RG);
    const float lg = loggamma2(h);
    const float cd = __builtin_amdgcn_exp2f(128.0f * lg), qdec = __builtin_amdgcn_exp2f((float)(32 * rb + r + 1) * lg);
    const int ls = tid & 127, lc = tid >> 7; const int n0 = 4 * g + 1;
    u32x4 kreg[2], vreg[4];
    { const int rowbase = b * 4096 + 128 * (n0 - 1);
#pragma unroll
      for (int i = 0; i < 2; ++i) kreg[i] = *(const u32x4*)(RK + (size_t)(rowbase + ls) * 512 + 64 * h + 8 * (lc + 4 * i));
#pragma unroll
      for (int i = 0; i < 4; ++i) vreg[i] = *(const u32x4*)(RV + (size_t)(rowbase + ls) * 1024 + 128 * h + 8 * (lc + 4 * i)); }
    const u32x4* kvsrc = (const u32x4*)(ws + WS_KV + ((size_t)((b * 8 + h) * 33) * 8 + wave) * 2048) + 2 * lane;
    f32x16 rs;
#pragma unroll
    for (int i = 0; i < 16; ++i) rs[i] = 0.f;
#pragma unroll 8
    for (int m = 0; m < n0; ++m) { const u32x4 a0 = kvsrc[(size_t)m * 1024], a1 = kvsrc[(size_t)m * 1024 + 1]; const unsigned* q0 = (const unsigned*)&a0; const unsigned* q1 = (const unsigned*)&a1;
#pragma unroll
        for (int e = 0; e < 4; ++e) { rs[2 * e] = rs[2 * e] * cd + __builtin_bit_cast(float, q0[e] << 16); rs[2 * e + 1] = rs[2 * e + 1] * cd + __builtin_bit_cast(float, q0[e] & 0xffff0000u);
            rs[8 + 2 * e] = rs[8 + 2 * e] * cd + __builtin_bit_cast(float, q1[e] << 16); rs[8 + 2 * e + 1] = rs[8 + 2 * e + 1] * cd + __builtin_bit_cast(float, q1[e] & 0xffff0000u); } }
    const float* gnp = ret_gn + 128 * h + 64 * dh + 4 * hi;
#pragma unroll 1
    for (int c = 0; c < 4; ++c) {
        const int n = n0 + c; const int rowbase = b * 4096 + 128 * (n - 1);
        bf16x8 qf[4];
#pragma unroll
        for (int s = 0; s < 4; ++s) qf[s] = *(const bf16x8*)(RQ + (size_t)(rowbase + 32 * rb + r) * 512 + 64 * h + 16 * s + 8 * hi);
        unsigned short* gp = RG + (size_t)(rowbase + 32 * rb + r) * 1024 + 128 * h + 64 * dh + 4 * hi;
        u32x2 rgv[8];
#pragma unroll
        for (int j = 0; j < 8; ++j) rgv[j] = *(const u32x2*)(gp + 32 * (j >> 2) + 8 * (j & 3));
#pragma unroll
        for (int i = 0; i < 2; ++i) *(LAS u32x4*)(lds + K_OFF + ls * KSTR + (lc + 4 * i) * 16) = kreg[i];
#pragma unroll
        for (int i = 0; i < 4; ++i) scatter_t(lds + VT_OFF, lc + 4 * i, ls, vreg[i]);
#pragma unroll
        for (int i = 0; i < 16; i += 2) { const unsigned w = cvtpk(rs[i], rs[i + 1]);
            *(LAS unsigned short*)(lds + RT_OFF + (32 * et + crow(i, hi)) * KSTR + (32 * dtl + r) * 2) = (unsigned short)(w & 0xffffu);
            *(LAS unsigned short*)(lds + RT_OFF + (32 * et + crow(i + 1, hi)) * KSTR + (32 * dtl + r) * 2) = (unsigned short)(w >> 16); }
        __syncthreads();
        const u32x4 kv0 = kvsrc[(size_t)n * 1024], kv1 = kvsrc[(size_t)n * 1024 + 1];
        if (c < 3) { const int rbn = rowbase + 128;
#pragma unroll
            for (int i = 0; i < 2; ++i) kreg[i] = *(const u32x4*)(RK + (size_t)(rbn + ls) * 512 + 64 * h + 8 * (lc + 4 * i));
#pragma unroll
            for (int i = 0; i < 4; ++i) vreg[i] = *(const u32x4*)(RV + (size_t)(rbn + ls) * 1024 + 128 * h + 8 * (lc + 4 * i)); }
        f32x16 o[2];
#pragma unroll
        for (int i = 0; i < 16; ++i) { o[0][i] = 0.f; o[1][i] = 0.f; }
#pragma unroll 1
        for (int sb = 0; sb <= rb; ++sb) {
            f32x16 p;
#pragma unroll
            for (int i = 0; i < 16; ++i) p[i] = 0.f;
            LAS const unsigned char* kp = lds + K_OFF + (32 * sb + r) * KSTR + hi * 16;
#pragma unroll
            for (int s = 0; s < 4; ++s) p = __builtin_amdgcn_mfma_f32_32x32x16_bf16(*(LAS const bf16x8*)(kp + 32 * s), qf[s], p, 0, 0, 0);
            unsigned pw[8]; const int dl0 = 32 * (rb - sb) + r;
#pragma unroll
            for (int i = 0; i < 16; i += 2) { const int d0 = dl0 - crow(i, hi), d1 = d0 - 1;
                const float a0 = d0 >= 0 ? p[i] * __builtin_amdgcn_exp2f((float)d0 * lg) : 0.f, a1 = d1 >= 0 ? p[i + 1] * __builtin_amdgcn_exp2f((float)d1 * lg) : 0.f;
                pw[i >> 1] = cvtpk(a0, a1); }
            const u32x4 pb0 = {pw[0], pw[1], pw[2], pw[3]}, pb1 = {pw[4], pw[5], pw[6], pw[7]};
#pragma unroll
            for (int e2 = 0; e2 < 2; ++e2) {
                LAS const unsigned char* vp = lds + VT_OFF + (32 * (2 * dh + e2) + r) * TSTR + (32 * sb + 4 * hi) * 2;
                const u32x2 a0 = *(LAS const u32x2*)(vp), a1 = *(LAS const u32x2*)(vp + 16), b0 = *(LAS const u32x2*)(vp + 32), b1 = *(LAS const u32x2*)(vp + 48);
                const u32x4 v0 = {a0.x, a0.y, a1.x, a1.y}, v1 = {b0.x, b0.y, b1.x, b1.y};
                o[e2] = __builtin_amdgcn_mfma_f32_32x32x16_bf16(__builtin_bit_cast(bf16x8, v0), __builtin_bit_cast(bf16x8, pb0), o[e2], 0, 0, 0);
                o[e2] = __builtin_amdgcn_mfma_f32_32x32x16_bf16(__builtin_bit_cast(bf16x8, v1), __builtin_bit_cast(bf16x8, pb1), o[e2], 0, 0, 0);
            }
        }
#pragma unroll
        for (int e2 = 0; e2 < 2; ++e2) { f32x16 x;
#pragma unroll
            for (int i = 0; i < 16; ++i) x[i] = 0.f;
            LAS const unsigned char* rp = lds + RT_OFF + (32 * (2 * dh + e2) + r) * KSTR + hi * 16;
#pragma unroll
            for (int s = 0; s < 4; ++s) x = __builtin_amdgcn_mfma_f32_32x32x16_bf16(*(LAS const bf16x8*)(rp + 32 * s), qf[s], x, 0, 0, 0);
#pragma unroll
            for (int i = 0; i < 16; ++i) o[e2][i] += x[i] * qdec; }
        float s1 = 0.f, s2 = 0.f;
#pragma unroll
        for (int i = 0; i < 16; ++i) { s1 += o[0][i] + o[1][i]; s2 += o[0][i] * o[0][i] + o[1][i] * o[1][i]; }
        s1 += __shfl_xor(s1, 32); s2 += __shfl_xor(s2, 32);
        LAS f32x2* gnx = (LAS f32x2*)(lds + GN_OFF);
        if (hi == 0) gnx[dh * 128 + 32 * rb + r] = (f32x2){s1, s2};
        __syncthreads();
        { const f32x2 ot = gnx[(dh ^ 1) * 128 + 32 * rb + r]; s1 += ot.x; s2 += ot.y; }
        const float mu = s1 * (1.0f / 128.0f); const float rstd = __builtin_amdgcn_rsqf(fmaxf(s2 * (1.0f / 128.0f) - mu * mu, 0.f) + EPS);
#pragma unroll
        for (int e2 = 0; e2 < 2; ++e2)
#pragma unroll
            for (int gq = 0; gq < 4; ++gq) { const f32x4 gv = *(const f32x4*)(gnp + 32 * e2 + 8 * gq); const u32x2 rg = rgv[4 * e2 + gq];
                const float y0 = (o[e2][4 * gq] - mu) * rstd * gv[0] * __builtin_bit_cast(float, rg.x << 16), y1 = (o[e2][4 * gq + 1] - mu) * rstd * gv[1] * __builtin_bit_cast(float, rg.x & 0xffff0000u);
                const float y2 = (o[e2][4 * gq + 2] - mu) * rstd * gv[2] * __builtin_bit_cast(float, rg.y << 16), y3 = (o[e2][4 * gq + 3] - mu) * rstd * gv[3] * __builtin_bit_cast(float, rg.y & 0xffff0000u);
                u32x2 w; w.x = cvtpk(y0, y1); w.y = cvtpk(y2, y3); *(u32x2*)(gp + 32 * e2 + 8 * gq) = w; }
        { const unsigned* q0 = (const unsigned*)&kv0; const unsigned* q1 = (const unsigned*)&kv1;
#pragma unroll
          for (int e = 0; e < 4; ++e) { rs[2 * e] = rs[2 * e] * cd + __builtin_bit_cast(float, q0[e] << 16); rs[2 * e + 1] = rs[2 * e + 1] * cd + __builtin_bit_cast(float, q0[e] & 0xffff0000u);
              rs[8 + 2 * e] = rs[8 + 2 * e] * cd + __builtin_bit_cast(float, q1[e] << 16); rs[8 + 2 * e + 1] = rs[8 + 2 * e + 1] * cd + __builtin_bit_cast(float, q1[e] & 0xffff0000u); } }
    }
    __syncthreads();
}

constexpr int N_SB = 512, N_KV = 32 * 33, N_ITEMS1 = N_SB + N_KV + 16, N_ITEMS2 = 256;
template <int PHASE> __device__ __forceinline__ void mixer_phase(unsigned char* ws, const float* ret_gn, LAS unsigned char* lds, volatile LAS unsigned* slot, unsigned* ctr, int tid_in) {
    int tid = tid_in; asm volatile("" : "+v"(tid));
    for (;;) {
        __syncthreads();
        if (tid == 0) slot[0] = __hip_atomic_fetch_add(ctr, 1u, __ATOMIC_RELAXED, __HIP_MEMORY_SCOPE_AGENT);
        __syncthreads();
        const int idx = (int)slot[0];
        if (PHASE == 1) {
            if (idx >= N_ITEMS1) break;
            if (idx < N_SB) { const int j = 15 - (idx >> 5), bh = idx & 31; sbk::sb_unit(ws, lds, bh >> 3, bh & 7, 128 + 256 * j, 256, tid); }
            else if (idx < N_SB + N_KV) { const int q = idx - N_SB, bh = q / 33, n = q - 33 * bh; kv_item(ws, lds, bh >> 3, bh & 7, n, tid); }
            else if (idx < N_SB + N_KV + 8) { const int hh = idx - N_SB - N_KV; sbk::sb_unit(ws, lds, 0, hh, 0, 128, tid); }
            else out_item(ws, ret_gn, lds, 0, idx - N_SB - N_KV - 8, 0, tid);
        } else {
            if (idx >= N_ITEMS2) break;
            { const int g = 7 - (idx >> 5), bh = idx & 31; out_group(ws, ret_gn, lds, bh >> 3, bh & 7, g, tid); }
        }
    }
}
}
namespace mini {
typedef short bf16x8 __attribute__((ext_vector_type(8)));
typedef float f32x4 __attribute__((ext_vector_type(4)));
typedef unsigned u32x2 __attribute__((ext_vector_type(2)));
using pg8::cvt_pk_bf16; using pg8::ss_t; using pg8::rowscale; using pg8::fsigmoid; using pg8::bflo; using pg8::bfhi;
template <int K> __device__ __forceinline__ f32x4 part(const unsigned short* A, const unsigned short* B, int wave, int lane) {
    constexpr int nks = K >> 8;
    const int rr = lane & 15, kg = lane >> 4;
    const unsigned short* ap = A + (size_t)rr * K + 32 * nks * wave + 8 * kg; const unsigned short* bp = B + (size_t)rr * K + 32 * nks * wave + 8 * kg;
    bf16x8 av[nks], bv[nks];
#pragma unroll
    for (int ks = 0; ks < nks; ++ks) { av[ks] = *(const bf16x8*)(ap + 32 * ks); bv[ks] = *(const bf16x8*)(bp + 32 * ks); }
    f32x4 acc = {0.f, 0.f, 0.f, 0.f};
#pragma unroll
    for (int ks = 0; ks < nks; ++ks) acc = __builtin_amdgcn_mfma_f32_16x16x32_bf16(bv[ks], av[ks], acc, 0, 0, 0);
    return acc;
}
template <bool TWO, int K0, int K1> __device__ __forceinline__ void task(LAS unsigned char* lds, const unsigned short* A0, const unsigned short* B0, const unsigned short* A1, const unsigned short* B1,
                                                          f32x4& r0, f32x4& r1, int wave, int lane) {
    LAS f32x4* red = (LAS f32x4*)lds;
    const f32x4 p0 = part<K0>(A0, B0, wave, lane); red[wave * 64 + lane] = p0;
    if (TWO) { const f32x4 p1 = part<K1>(A1, B1, wave, lane); red[512 + wave * 64 + lane] = p1; }
    __syncthreads();
    if (wave == 0) { f32x4 s = red[lane], t = {0.f, 0.f, 0.f, 0.f};
#pragma unroll
        for (int w = 1; w < 8; ++w) s = s + red[w * 64 + lane];
        if (TWO) { t = red[512 + lane];
#pragma unroll
            for (int w = 1; w < 8; ++w) t = t + red[512 + w * 64 + lane]; }
        r0 = s; r1 = t; }
}
__device__ __forceinline__ void st4(unsigned short* p, f32x4 v) { u32x2 w; w.x = cvt_pk_bf16(v[0], v[1]); w.y = cvt_pk_bf16(v[2], v[3]); *(u32x2*)p = w; }

__device__ __forceinline__ void gu(unsigned char* ws, LAS unsigned char* lds, const unsigned short* Wt, const ss_t* ss, int vcu, int G, int tid_in) {
    int tid = tid_in; asm volatile("" : "+v"(tid)); asm volatile("" : "+s"(vcu)); const int lane = tid & 63, wave = __builtin_amdgcn_readfirstlane(tid >> 6), row = lane & 15, cq = lane >> 4;
    const unsigned short* A = (const unsigned short*)(ws + WS_HB) + (size_t)MR * 1024;
    for (int t = vcu; t < 176; t += G) { const int f0 = 16 * t, wr = 256 * (f0 >> 7) + (f0 & 127); f32x4 a, b;
        task<true, 1024, 1024>(lds, A, Wt + (size_t)wr * 1024, A, Wt + (size_t)(wr + 128) * 1024, a, b, wave, lane);
        if (wave == 0) { const float r = rowscale(ss, MR + row); f32x4 o;
#pragma unroll
            for (int e = 0; e < 4; ++e) { const float x = a[e] * r, y = b[e] * r; o[e] = x * fsigmoid(x) * y; }
            st4((unsigned short*)(ws + WS_ACT) + (size_t)(MR + row) * 2816 + f0 + 4 * cq, o); }
        __syncthreads(); }
}
template <int K> __device__ __forceinline__ void resid(unsigned char* ws, LAS unsigned char* lds, const unsigned short* A, const unsigned short* Wt, ss_t* ssn, float s, int vcu, int G, int tid_in) {
    int tid = tid_in; asm volatile("" : "+v"(tid)); asm volatile("" : "+s"(vcu)); const int lane = tid & 63, wave = __builtin_amdgcn_readfirstlane(tid >> 6), row = lane & 15, cq = lane >> 4;
    for (int t = vcu; t < 64; t += G) { f32x4 a, b;
        task<false, K, 256>(lds, A + (size_t)MR * K, Wt + (size_t)(16 * t) * K, nullptr, nullptr, a, b, wave, lane);
        if (wave == 0) { float* hp = (float*)(ws + WS_HSIDE) + (size_t)row * 1024 + 16 * t + 4 * cq; f32x4 v = *(const f32x4*)hp; v = v + a * s; *(f32x4*)hp = v;
            st4((unsigned short*)(ws + WS_HB) + (size_t)(MR + row) * 1024 + 16 * t + 4 * cq, v);
            float sq = (v[0] * v[0] + v[1] * v[1]) + (v[2] * v[2] + v[3] * v[3]); sq += __shfl_xor(sq, 16); sq += __shfl_xor(sq, 32);
            if (cq == 0) atomicAdd(ssn + MR + row, (ss_t)(sq * 1048576.0f + 0.5f)); }
        __syncthreads(); }
}
__device__ __forceinline__ void inproj(unsigned char* ws, LAS unsigned char* lds, const unsigned short* Wt, const ss_t* ss, bool first, int vcu, int G, int tid_in) {
    int tid = tid_in; asm volatile("" : "+v"(tid)); asm volatile("" : "+s"(vcu)); const int lane = tid & 63, wave = __builtin_amdgcn_readfirstlane(tid >> 6), row = lane & 15, cq = lane >> 4;
    const unsigned short* A = (const unsigned short*)(ws + WS_HB) + (size_t)MR * 1024;
    const int nrot = first ? 32 : 0, c_lo = first ? 1024 : 4608, nplain = first ? 224 : 128;
    for (int t = vcu; t < nrot + nplain; t += G) { f32x4 a, b;
        if (t < nrot) { const int qk = t >> 4, head = (t >> 1) & 7, d0 = 16 * (t & 1); const int wr = 256 * (2 * qk + (head >> 2)) + 32 * (head & 3) + d0;
            task<true, 1024, 1024>(lds, A, Wt + (size_t)wr * 1024, A, Wt + (size_t)(wr + 128) * 1024, a, b, wave, lane);
            if (wave == 0) { const float r = rowscale(ss, MR + row) * (qk ? 0.125f : 1.0f); const int d = d0 + 4 * cq; const float* tp = (const float*)(ws + WS_TAB) + ((size_t)(112 + row) * 32 + d) * 2; f32x4 o1, o2;
#pragma unroll
                for (int e = 0; e < 4; ++e) { const float c = tp[2 * e], s = tp[2 * e + 1], t1 = a[e] * r, t2 = b[e] * r; o1[e] = t1 * c - t2 * s; o2[e] = t1 * s + t2 * c; }
                unsigned short* op = (unsigned short*)(ws + (qk ? WS_RK : WS_RQ)) + (size_t)(MR + row) * 512 + 64 * head + d; st4(op, o1); st4(op + 32, o2); }
        } else { const int c0 = c_lo + 16 * (t - nrot);
            task<false, 1024, 256>(lds, A, Wt + (size_t)c0 * 1024, nullptr, nullptr, a, b, wave, lane);
            if (wave == 0) { size_t off; int pitch, cb, act; float sc = 1.0f;
                if (c0 < 2048) { off = WS_RV; pitch = 1024; cb = 1024; act = 0; } else if (c0 < 3072) { off = WS_RG; pitch = 1024; cb = 2048; act = 1; }
                else if (c0 < 3584) { off = WS_SQ; pitch = 512; cb = 3072; act = 0; sc = SBC2; } else if (c0 < 4096) { off = WS_SK; pitch = 512; cb = 3584; act = 0; }
                else if (c0 < 4608) { off = WS_SV; pitch = 512; cb = 4096; act = 0; } else if (c0 < 5632) { off = WS_GA; pitch = 1024; cb = 4608; act = 2; } else { off = WS_GB; pitch = 1024; cb = 5632; act = 2; }
                const float r = rowscale(ss, MR + row) * sc; f32x4 o;
#pragma unroll
                for (int e = 0; e < 4; ++e) { float v = a[e] * r; if (act == 1) v = v * fsigmoid(v); else if (act == 2) v = fsigmoid(v); o[e] = v; }
                st4((unsigned short*)(ws + off) + (size_t)(MR + row) * pitch + (c0 - cb) + 4 * cq, o); }
        }
        __syncthreads(); }
}
__device__ __forceinline__ void proj(unsigned char* ws, LAS unsigned char* lds, const unsigned short* Wret, const unsigned short* Wsb, int vcu, int G, int tid_in) {
    int tid = tid_in; asm volatile("" : "+v"(tid)); asm volatile("" : "+s"(vcu)); const int lane = tid & 63, wave = __builtin_amdgcn_readfirstlane(tid >> 6), row = lane & 15, cq = lane >> 4;
    for (int t = vcu; t < 64; t += G) { f32x4 a, b;
        task<true, 1024, 512>(lds, (const unsigned short*)(ws + WS_RG) + (size_t)MR * 1024, Wret + (size_t)(16 * t) * 1024, (const unsigned short*)(ws + WS_SQ) + (size_t)MR * 512, Wsb + (size_t)(16 * t) * 512, a, b, wave, lane);
        if (wave == 0) { const size_t o = (size_t)(MR + row) * 1024 + 16 * t + 4 * cq; const u32x2 ga = *(const u32x2*)((const unsigned short*)(ws + WS_GA) + o), gb = *(const u32x2*)((const unsigned short*)(ws + WS_GB) + o);
            f32x4 y; y[0] = bflo(ga.x) * a[0] + bflo(gb.x) * b[0]; y[1] = bfhi(ga.x) * a[1] + bfhi(gb.x) * b[1]; y[2] = bflo(ga.y) * a[2] + bflo(gb.y) * b[2]; y[3] = bfhi(ga.y) * a[3] + bfhi(gb.y) * b[3];
            st4((unsigned short*)(ws + WS_Y) + o, y); }
        __syncthreads(); }
}
}
#ifndef PHMASK
#define PHMASK 0xFFFF
#endif
struct Args { In in; float* out; unsigned char* ws; int ph_lo, ph_hi; };
__global__ void __launch_bounds__(NWAVES * 64, 2) fwd_mega(Args args) {
    extern __shared__ __attribute__((aligned(16))) unsigned char lds_raw[];
    LAS unsigned char* lds = (LAS unsigned char*)lds_raw;
    volatile LAS unsigned* MISC = (volatile LAS unsigned*)(lds + MISC_OFF);
    const int tid = threadIdx.x, lane = tid & 63, wave = __builtin_amdgcn_readfirstlane(tid >> 6);
    const int G = gridDim.x; const int bx = blockIdx.x; const int vcu = (G % 8 == 0) ? (bx % 8) * (G / 8) + bx / 8 : bx;
    for (int u = tid; u < 64; u += NWAVES * 64) MISC[u] = 0u;
    __syncthreads();
    unsigned char* ws = args.ws; const In& in = args.in;
    XcdBarrier bar = xcd_barrier_post((unsigned*)(ws + WS_CTL) + CW_BAR, MISC + 8);
    const int gw = vcu * NWAVES + wave, NGW = G * NWAVES;
    pg8::ss_t* ssb = (pg8::ss_t*)(ws + WS_SS);
    pg8::bf16_t* HB = (pg8::bf16_t*)(ws + WS_HB);
    float* hside = (float*)(ws + WS_HSIDE);
#define WPTR(off) ((const pg8::bf16_t*)(ws + WS_W + (off)))
#define GRID_BAR() xcd_barrier(bar)

    convert_range(in, 0, CV_GU1, CV_GU2, ws, lds, gw, NGW, wave, lane);
    init_rows(in, args.out, ws, gw, NGW, lane);
    if (args.ph_lo == 0x7ead) cg::this_grid().sync(); else GRID_BAR();

#pragma unroll
    for (int l = 0; l < 2; ++l) {
        const pg8::ss_t* ss_a = ssb + (size_t)(3 * l) * M; pg8::ss_t* ss_b = ssb + (size_t)(3 * l + 1) * M; pg8::ss_t* ss_c = ssb + (size_t)(3 * l + 2) * M; pg8::ss_t* ss_d = ssb + (size_t)(3 * l + 3) * M;
        #if PHMASK & 1
        mini::gu(ws, lds, (const unsigned short*)WPTR(W_GU1), ss_a, vcu, G, tid);
        { pg8::Gemm g{HB, WPTR(W_GU1), MR, 2 * DFF, DM}; pg8::StaticOrder S; S.init(MR, 2 * DFF, G, bx);
          pg8::EpiSwiGLU E{(pg8::bf16_t*)(ws + WS_ACT), ss_a};
          pg8::gemm_phase<pg8::EpiSwiGLU, pg8::StaticOrder, true, true>(lds, g, S, E); }
          if (G == 256) { int bxs = bx; asm volatile("" : "+s"(bxs)); const int sgw = (bxs - 128) * NWAVES + wave; if (bxs >= 128) {        convert_range(in, l, CV_DN1, CV_DN2, ws, lds, sgw, 1024, wave, lane); convert_range(in, l, CV_IN, CV_RSO, ws, lds, sgw, 1024, wave, lane); } }
          else { convert_range(in, l, CV_DN1, CV_DN2, ws, lds, gw, NGW, wave, lane); convert_range(in, l, CV_IN, CV_RSO, ws, lds, gw, NGW, wave, lane); }

#endif
        GRID_BAR();
        #if PHMASK & 2
        mini::resid<DFF>(ws, lds, (const unsigned short*)(ws + WS_ACT), (const unsigned short*)WPTR(W_DN1), ss_b, 0.5f, vcu, G, tid);
        { pg8::Gemm g{(const pg8::bf16_t*)(ws + WS_ACT), WPTR(W_DN1), MR, DM, DFF}; pg8::StaticOrder S; S.init(MR, DM, G, bx);
          pg8::EpiResid E{l == 0 ? in.x : (const float*)args.out, args.out, HB, ss_b, 0.5f};
          pg8::gemm_phase<pg8::EpiResid, pg8::StaticOrder, true, true>(lds, g, S, E); }

#endif
        GRID_BAR();
        #if PHMASK & 4
        mini::inproj(ws, lds, (const unsigned short*)WPTR(W_IN), ss_b, true, vcu, G, tid);
        { pg8::Gemm g{HB, WPTR(W_IN), MR, 4608, DM}; pg8::StaticOrder S; S.init(MR, 4608, G, bx);
          pg8::EpiIn E{ws, ss_b, 0};
          pg8::gemm_phase<pg8::EpiIn, pg8::StaticOrder, true, true>(lds, g, S, E); }
          if (G == 256) { int bxs = bx; asm volatile("" : "+s"(bxs)); const int sgw = (bxs - 128) * NWAVES + wave; if (bxs >= 128) {        convert_range(in, l, CV_RSO, CV_END, ws, lds, sgw, 1024, wave, lane); convert_range(in, l, CV_GU2, CV_DN1, ws, lds, sgw, 1024, wave, lane); } }
          else { convert_range(in, l, CV_RSO, CV_END, ws, lds, gw, NGW, wave, lane); convert_range(in, l, CV_GU2, CV_DN1, ws, lds, gw, NGW, wave, lane); }

#endif
        GRID_BAR();
        #if PHMASK & 8
        retk::mixer_phase<1>(ws, in.ret_gn + l * 1024, lds, MISC + 16, (unsigned*)(ws + WS_CTL) + CW_Q + 128 * l, tid);
        GRID_BAR();
        retk::mixer_phase<2>(ws, in.ret_gn + l * 1024, lds, MISC + 16, (unsigned*)(ws + WS_CTL) + CW_Q + 128 * l + 64, tid);

#endif
        GRID_BAR();
        #if PHMASK & 16
        mini::inproj(ws, lds, (const unsigned short*)WPTR(W_IN), ss_b, false, vcu, G, tid);
        { pg8::Gemm g{HB, WPTR(W_IN) + (size_t)4608 * DM, MR, 2048, DM}; pg8::StaticOrder S; S.init(MR, 2048, G, bx);
          pg8::EpiIn E{ws, ss_b, 18};
          pg8::gemm_phase<pg8::EpiIn, pg8::StaticOrder, true, true>(lds, g, S, E); }

#endif
        GRID_BAR();
        #if PHMASK & 32
        mini::proj(ws, lds, (const unsigned short*)WPTR(W_RET), (const unsigned short*)WPTR(W_SB), vcu, G, tid);
        { pg8::Gemm g{(const pg8::bf16_t*)(ws + WS_RG), WPTR(W_RET), MR, DM, DM}; pg8::StaticOrder S; S.init(MR, DM, G, bx);
          pg8::EpiProj<true> E{(const pg8::bf16_t*)(ws + WS_GA), (pg8::bf16_t*)(ws + WS_Y)};
          pg8::gemm_phase<pg8::EpiProj<true>, pg8::StaticOrder, true, true>(lds, g, S, E); }
        asm volatile("s_waitcnt vmcnt(0)" ::: "memory"); __syncthreads();
        { pg8::Gemm g{(const pg8::bf16_t*)(ws + WS_SQ), WPTR(W_SB), MR, DM, 512}; pg8::StaticOrder S; S.init(MR, DM, G, bx);
          pg8::EpiProj<false> E{(const pg8::bf16_t*)(ws + WS_GB), (pg8::bf16_t*)(ws + WS_Y)};
          pg8::gemm_phase<pg8::EpiProj<false>, pg8::StaticOrder, true, true>(lds, g, S, E); }

#endif
        GRID_BAR();
        #if PHMASK & 64
        mini::resid<DM>(ws, lds, (const unsigned short*)(ws + WS_Y), (const unsigned short*)WPTR(W_OUT), ss_c, 1.0f, vcu, G, tid);
        { pg8::Gemm g{(const pg8::bf16_t*)(ws + WS_Y), WPTR(W_OUT), MR, DM, DM}; pg8::StaticOrder S; S.init(MR, DM, G, bx);
          pg8::EpiResid E{args.out, args.out, HB, ss_c, 1.0f};
          pg8::gemm_phase<pg8::EpiResid, pg8::StaticOrder, true, true>(lds, g, S, E); }

#endif
        GRID_BAR();
        #if PHMASK & 128
        mini::gu(ws, lds, (const unsigned short*)WPTR(W_GU2), ss_c, vcu, G, tid);
        { pg8::Gemm g{HB, WPTR(W_GU2), MR, 2 * DFF, DM}; pg8::StaticOrder S; S.init(MR, 2 * DFF, G, bx);
          pg8::EpiSwiGLU E{(pg8::bf16_t*)(ws + WS_ACT), ss_c};
          pg8::gemm_phase<pg8::EpiSwiGLU, pg8::StaticOrder, true, true>(lds, g, S, E); }
          if (G == 256) { int bxs = bx; asm volatile("" : "+s"(bxs)); const int sgw = (bxs - 128) * NWAVES + wave; if (bxs >= 128) {        convert_range(in, l, CV_DN2, CV_IN, ws, lds, sgw, 1024, wave, lane); if (l == 0) convert_range(in, 1, CV_GU1, CV_GU2, ws, lds, sgw, 1024, wave, lane); } }
          else { convert_range(in, l, CV_DN2, CV_IN, ws, lds, gw, NGW, wave, lane); if (l == 0) convert_range(in, 1, CV_GU1, CV_GU2, ws, lds, gw, NGW, wave, lane); }

#endif
        GRID_BAR();
        #if PHMASK & 256
        mini::resid<DFF>(ws, lds, (const unsigned short*)(ws + WS_ACT), (const unsigned short*)WPTR(W_DN2), ss_d, 0.5f, vcu, G, tid);
        { pg8::Gemm g{(const pg8::bf16_t*)(ws + WS_ACT), WPTR(W_DN2), MR, DM, DFF}; pg8::StaticOrder S; S.init(MR, DM, G, bx);
          pg8::EpiResid E{args.out, args.out, HB, ss_d, 0.5f};
          pg8::gemm_phase<pg8::EpiResid, pg8::StaticOrder, true, true>(lds, g, S, E); }

#endif
        GRID_BAR();
    }
    final_norm(in, args.out, ws, gw, NGW, lane);
}

extern "C" void kernel_launch(void* const* d_in, const int* in_sizes, int n_in, void* d_out, int out_size, void* d_ws, size_t ws_size, hipStream_t stream) {
    static int grid = 0;
    if (grid == 0) {
        int dev = 0, cus = 0, per_cu = 0;
        if (n_in != 15 || out_size != MR * DM || ws_size < 256 * MiB) { fprintf(stderr, "kernel_launch: unexpected shapes n_in %d out %d ws %zu (need %zu)\n", n_in, out_size, ws_size, (size_t)WS_END); grid = -1; return; }
        (void)hipGetDevice(&dev); (void)hipDeviceGetAttribute(&cus, hipDeviceAttributeMultiprocessorCount, dev);
        (void)hipFuncSetAttribute((const void*)fwd_mega, hipFuncAttributeMaxDynamicSharedMemorySize, LDS_BYTES);
        (void)hipOccupancyMaxActiveBlocksPerMultiprocessor(&per_cu, (const void*)fwd_mega, NWAVES * 64, LDS_BYTES);
        if (per_cu < 1) per_cu = 1;
        grid = cus * per_cu;
    }
    if (grid < 0) return;
    (void)hipMemsetAsync((char*)d_ws + WS_CTL, 0, CTL_ZERO_BYTES, stream);
    Args a{};
    const float** ip = (const float**)&a.in;
    for (int i = 0; i < 15; ++i) ip[i] = (const float*)d_in[i];
    a.out = (float*)d_out; a.ws = (unsigned char*)d_ws; a.ph_lo = 0; a.ph_hi = 0;
    void* kargs[] = {&a};
    hipError_t e = hipLaunchCooperativeKernel((const void*)fwd_mega, dim3(grid), dim3(NWAVES * 64), kargs, LDS_BYTES, stream);
    if (e != hipSuccess) fprintf(stderr, "kernel_launch: cooperative launch failed: %s (grid %d)\n", hipGetErrorString(e), grid);
}
```
